# Optimizing an MI355X kernel written in HIP

```python
import math
import jax, jax.numpy as jnp
from jax import lax
import numpy as np

D_MODEL = 1024
BATCH = 32
SEQ = 2048
DEPTH = 4
DEC_BATCH = 8
DEC_SEQ = 32
PAST_LEN = 1024

CHUNK = 64
Q_BLOCK = 128
D_MIX = D_MODEL
DA_HEADS = 4
DA_WIDTH = D_MIX // 2
DA_DV = DA_WIDTH // DA_HEADS
DA_DK = DA_DV // 2
ROT_DIM = DA_DK // 4
ROPE_THETA = 500000.0
GM_WIDTH = D_MIX - DA_WIDTH
GM_GROUPS = 4
GM_CH = GM_WIDTH // GM_GROUPS
GM_CHUNK = 128
MEM_LEN = 256
X_HEADS = 4
X_DH = D_MODEL // X_HEADS
D_FF = 2816
CONV_W = 3
EPS = 1e-6
DA_QK_COLS = DA_HEADS * 2 * DA_DK
IN_COLS = 2 * DA_QK_COLS + DA_WIDTH + 2 * GM_WIDTH
NEG = float(np.finfo(np.float32).min)

kernel_name = "hybrid_diffattn_gmlp_streaming_step"


def rmsnorm(x, g):
    xf = x.astype(jnp.float32)
    y = xf * lax.rsqrt(jnp.mean(xf * xf, axis=-1, keepdims=True) + EPS)
    return (y * g.astype(jnp.float32)).astype(x.dtype)


def partial_rope(x, pos):
    half = ROT_DIM // 2
    inv = ROPE_THETA ** (-jnp.arange(half, dtype=jnp.float32) / half)
    ang = pos.astype(jnp.float32)[:, None] * inv[None, :]
    cos = jnp.cos(ang)[:, None, None, :]
    sin = jnp.sin(ang)[:, None, None, :]
    x1 = x[..., :half].astype(jnp.float32)
    x2 = x[..., half:ROT_DIM].astype(jnp.float32)
    rot = jnp.concatenate([x1 * cos - x2 * sin, x2 * cos + x1 * sin], axis=-1)
    return jnp.concatenate([rot.astype(x.dtype), x[..., ROT_DIM:]], axis=-1)


def diff_attn_block(q, k, v, q_pos, k_pos, lam):
    s = jnp.einsum('bqhmd,bkhmd->bhmqk', q, k,
                   preferred_element_type=jnp.float32) * (DA_DK ** -0.5)
    mask = (k_pos[None, :] // CHUNK) <= (q_pos[:, None] // CHUNK)
    s = jnp.where(mask, s, NEG)
    p = jax.nn.softmax(s, axis=-1)
    a = p[:, :, 0] - lam * p[:, :, 1]
    return jnp.einsum('bhqk,bkhd->bqhd', a.astype(v.dtype), v)


def diff_attention(q, k, v, q_pos, k_pos, lam):
    B, Sq = q.shape[0], q.shape[1]
    if Sq > Q_BLOCK and Sq % Q_BLOCK == 0:
        nb = Sq // Q_BLOCK
        qb = q.reshape(B, nb, Q_BLOCK, DA_HEADS, 2, DA_DK).transpose(1, 0, 2, 3, 4, 5)
        pb = q_pos.reshape(nb, Q_BLOCK)
        out = lax.map(lambda a: diff_attn_block(a[0], k, v, a[1], k_pos, lam), (qb, pb))
        return out.transpose(1, 0, 2, 3, 4).reshape(B, Sq, DA_HEADS, DA_DV)
    return diff_attn_block(q, k, v, q_pos, k_pos, lam)


def spatial_gate(u, gv, w_s, b_s):
    B, S = u.shape[0], u.shape[1]
    L = min(S, GM_CHUNK)
    n = S // L
    tri = jnp.tril(jnp.ones((L, L), dtype=bool))
    w = jnp.where(tri[None], w_s[:, :L, :L], 0.0)
    vc = gv.reshape(B, n, L, GM_GROUPS, GM_CH)
    s = jnp.einsum('gts,bnsgc->bntgc', w, vc) + b_s[:, :L].T[None, None, :, :, None]
    return u * s.reshape(B, S, GM_WIDTH)


def mem_kv(mem, norm_g, wk, wv, kg):
    B, M, _ = mem.shape
    m = rmsnorm(mem, norm_g)
    k = rmsnorm((m @ wk).reshape(B, M, X_HEADS, X_DH), kg)
    v = (m @ wv).reshape(B, M, X_HEADS, X_DH)
    return k, v


def cross_attend(h, mk, mv, wq, wo, qg):
    B, S, _ = h.shape
    q = rmsnorm((h @ wq).reshape(B, S, X_HEADS, X_DH), qg)
    s = jnp.einsum('bqhd,bkhd->bhqk', q, mk,
                   preferred_element_type=jnp.float32) * (X_DH ** -0.5)
    p = jax.nn.softmax(s, axis=-1)
    o = jnp.einsum('bhqk,bkhd->bqhd', p.astype(mv.dtype), mv).reshape(B, S, D_MODEL)
    return o @ wo


def conv_ffn(h, hist, w_up, conv_w, conv_b, w_down):
    S = h.shape[1]
    g, up = jnp.split(h @ w_up, 2, axis=-1)
    gp = jnp.concatenate([hist, g], axis=1)
    c = conv_b + sum(conv_w[j] * gp[:, j:j + S] for j in range(CONV_W))
    a = jax.nn.silu(c) * up
    return a @ w_down, gp[:, -(CONV_W - 1):]


def trunk_layer(x, pos, past_k, past_v, mem_k, mem_v, conv_hist, w, lam_init):
    B, S, _ = x.shape
    h = rmsnorm(x, w['norm_mix_g'])
    z = h @ w['w_in']
    c1 = DA_QK_COLS
    c2 = 2 * DA_QK_COLS
    c3 = c2 + DA_WIDTH
    c4 = c3 + GM_WIDTH
    q, k, v, u, gv = jnp.split(z, [c1, c2, c3, c4], axis=-1)
    q = partial_rope(rmsnorm(q.reshape(B, S, DA_HEADS, 2, DA_DK), w['da_q_norm_g']), pos)
    k = partial_rope(rmsnorm(k.reshape(B, S, DA_HEADS, 2, DA_DK), w['da_k_norm_g']), pos)
    v = v.reshape(B, S, DA_HEADS, DA_DV)
    if past_k is None:
        k_all, v_all, k_pos = k, v, pos
    else:
        k_all = jnp.concatenate([past_k, k], axis=1)
        v_all = jnp.concatenate([past_v, v], axis=1)
        k_pos = jnp.arange(past_k.shape[1] + S)
    f32 = jnp.float32
    lam = (jnp.exp(jnp.sum(w['lambda_q1'].astype(f32) * w['lambda_k1'].astype(f32)))
           - jnp.exp(jnp.sum(w['lambda_q2'].astype(f32) * w['lambda_k2'].astype(f32)))
           + lam_init)
    o = diff_attention(q, k_all, v_all, pos, k_pos, lam)
    o = (rmsnorm(o, w['da_subln_g']) * (1.0 - lam_init)).reshape(B, S, DA_WIDTH)
    u = jax.nn.gelu(u)
    gv = rmsnorm(jax.nn.gelu(gv).reshape(B, S, GM_GROUPS, GM_CH), w['gm_norm_g'])
    g_out = spatial_gate(u, gv, w['gm_w_s'], w['gm_b'])
    x = x + jnp.concatenate([o, g_out], axis=-1) @ w['w_out']
    x = x + cross_attend(rmsnorm(x, w['norm_x_g']), mem_k, mem_v,
                         w['wq_c'], w['wo_c'], w['xq_norm_g'])
    f, conv_state = conv_ffn(rmsnorm(x, w['norm_ffn_g']), conv_hist,
                             w['w_up'], w['conv_w'], w['conv_b'], w['w_down'])
    return x + f, k, v, gv, conv_state


def setup_inputs(seed: int = 0) -> dict:
    key = jax.random.key(seed)
    ks = iter(jax.random.split(key, 40))
    f32 = jnp.float32

    def nrm(shape, scale):
        return scale * jax.random.normal(next(ks), shape, f32)

    def gain(shape):
        return 1.0 + 0.05 * jax.random.normal(next(ks), shape, f32)

    return {
        'x_prompt': nrm((BATCH, SEQ, D_MODEL), 1.0),
        'x_sample': nrm((DEC_BATCH, DEC_SEQ, D_MODEL), 1.0),
        'cache_da_k': nrm((DEPTH, DEC_BATCH, PAST_LEN, DA_HEADS, 2, DA_DK), 1.0),
        'cache_da_v': nrm((DEPTH, DEC_BATCH, PAST_LEN, DA_HEADS, DA_DV), 1.0),
        'cache_mem_k': nrm((DEPTH, DEC_BATCH, MEM_LEN, X_HEADS, X_DH), 1.0),
        'cache_mem_v': nrm((DEPTH, DEC_BATCH, MEM_LEN, X_HEADS, X_DH), 1.0),
        'state_ffn_conv': nrm((DEPTH, DEC_BATCH, CONV_W - 1, D_FF), 1.0),
        'mem_prompt': nrm((BATCH, MEM_LEN, D_MODEL), 1.0),
        'norm_mix_g': gain((DEPTH, D_MODEL)),
        'w_in': nrm((DEPTH, D_MODEL, IN_COLS), D_MODEL ** -0.5),
        'da_q_norm_g': gain((DEPTH, DA_DK)),
        'da_k_norm_g': gain((DEPTH, DA_DK)),
        'lambda_q1': nrm((DEPTH, DA_DK), 0.1),
        'lambda_k1': nrm((DEPTH, DA_DK), 0.1),
        'lambda_q2': nrm((DEPTH, DA_DK), 0.1),
        'lambda_k2': nrm((DEPTH, DA_DK), 0.1),
        'da_subln_g': gain((DEPTH, DA_DV)),
        'gm_norm_g': gain((DEPTH, GM_CH)),
        'gm_w_s': nrm((DEPTH, GM_GROUPS, GM_CHUNK, GM_CHUNK), GM_CHUNK ** -0.5),
        'gm_b': nrm((DEPTH, GM_GROUPS, GM_CHUNK), 0.02),
        'w_out': nrm((DEPTH, D_MIX, D_MODEL), D_MIX ** -0.5),
        'norm_x_g': gain((DEPTH, D_MODEL)),
        'norm_mem_g': gain((DEPTH, D_MODEL)),
        'wq_c': nrm((DEPTH, D_MODEL, D_MODEL), D_MODEL ** -0.5),
        'wk_c': nrm((DEPTH, D_MODEL, D_MODEL), D_MODEL ** -0.5),
        'wv_c': nrm((DEPTH, D_MODEL, D_MODEL), D_MODEL ** -0.5),
        'wo_c': nrm((DEPTH, D_MODEL, D_MODEL), D_MODEL ** -0.5),
        'xq_norm_g': gain((DEPTH, X_DH)),
        'xk_norm_g': gain((DEPTH, X_DH)),
        'norm_ffn_g': gain((DEPTH, D_MODEL)),
        'w_up': nrm((DEPTH, D_MODEL, 2 * D_FF), D_MODEL ** -0.5),
        'conv_w': nrm((DEPTH, CONV_W, D_FF), CONV_W ** -0.5),
        'conv_b': nrm((DEPTH, D_FF), 0.02),
        'w_down': nrm((DEPTH, D_FF, D_MODEL), D_FF ** -0.5),
    }


def reference(x_prompt, x_sample, cache_da_k, cache_da_v, cache_mem_k, cache_mem_v,
              state_ffn_conv, mem_prompt, norm_mix_g, w_in, da_q_norm_g, da_k_norm_g,
              lambda_q1, lambda_k1, lambda_q2, lambda_k2, da_subln_g, gm_norm_g,
              gm_w_s, gm_b, w_out, norm_x_g, norm_mem_g, wq_c, wk_c, wv_c, wo_c,
              xq_norm_g, xk_norm_g, norm_ffn_g, w_up, conv_w, conv_b, w_down):
    S_p = x_prompt.shape[1]
    S_s = x_sample.shape[1]
    past = cache_da_k.shape[2]
    pos_p = jnp.arange(S_p)
    pos_s = past + jnp.arange(S_s)
    hist_p = jnp.zeros((x_prompt.shape[0], CONV_W - 1, D_FF), x_prompt.dtype)

    xp, xs = x_prompt, x_sample
    dk_p, dv_p, mk_p, mv_p, fc_p = [], [], [], [], []
    dk_s, dv_s, gv_s, fc_s = [], [], [], []
    for l in range(DEPTH):
        lam_init = 0.8 - 0.6 * math.exp(-0.3 * l)
        w = dict(norm_mix_g=norm_mix_g[l], w_in=w_in[l], da_q_norm_g=da_q_norm_g[l],
                 da_k_norm_g=da_k_norm_g[l], lambda_q1=lambda_q1[l], lambda_k1=lambda_k1[l],
                 lambda_q2=lambda_q2[l], lambda_k2=lambda_k2[l], da_subln_g=da_subln_g[l],
                 gm_norm_g=gm_norm_g[l], gm_w_s=gm_w_s[l], gm_b=gm_b[l], w_out=w_out[l],
                 norm_x_g=norm_x_g[l], wq_c=wq_c[l], wo_c=wo_c[l], xq_norm_g=xq_norm_g[l],
                 norm_ffn_g=norm_ffn_g[l], w_up=w_up[l], conv_w=conv_w[l],
                 conv_b=conv_b[l], w_down=w_down[l])
        mk, mv = mem_kv(mem_prompt, norm_mem_g[l], wk_c[l], wv_c[l], xk_norm_g[l])
        xp, k_new, v_new, _, conv_new = trunk_layer(
            xp, pos_p, None, None, mk, mv, hist_p, w, lam_init)
        dk_p.append(k_new); dv_p.append(v_new); mk_p.append(mk); mv_p.append(mv)
        fc_p.append(conv_new)
        xs, k_new, v_new, gv_new, conv_new = trunk_layer(
            xs, pos_s, cache_da_k[l], cache_da_v[l], cache_mem_k[l], cache_mem_v[l],
            state_ffn_conv[l], w, lam_init)
        dk_s.append(k_new); dv_s.append(v_new); gv_s.append(gv_new); fc_s.append(conv_new)

    return (xp, xs, jnp.stack(dk_p), jnp.stack(dv_p), jnp.stack(mk_p), jnp.stack(mv_p),
            jnp.stack(fc_p), jnp.stack(dk_s), jnp.stack(dv_s), jnp.stack(gv_s),
            jnp.stack(fc_s))
```

```cpp
#include <hip/hip_runtime.h>
#include <hip/hip_cooperative_groups.h>
#include <cstdio>
#include <cstdint>
namespace cg = cooperative_groups;

#define LAS __attribute__((address_space(3)))
#define DI __device__ __forceinline__
typedef unsigned short bf16_t;
typedef short bf16x8 __attribute__((ext_vector_type(8)));
typedef float f32x4 __attribute__((ext_vector_type(4)));
typedef float f32x2 __attribute__((ext_vector_type(2)));
typedef float f32x16 __attribute__((ext_vector_type(16)));
typedef unsigned u32x4 __attribute__((ext_vector_type(4)));
typedef unsigned u32x2 __attribute__((ext_vector_type(2)));
typedef __bf16 bf16x2_t __attribute__((ext_vector_type(2)));

constexpr int DM = 1024, SEQ = 2048, NBATCH = 32, DEPTH = 4, RP = NBATCH * SEQ, DB = 8, DSEQ = 32, RS = DB * DSEQ, R = RP + RS;
constexpr int PAST = 1024, INC = 2560, DFF = 2816, UPC = 2 * DFF, MEMR = NBATCH * 256, NWAVES = 8, NTHR = 512;
constexpr float EPS = 1e-6f, LOG2E = 1.4426950408889634f;
constexpr float QSCALE = 0.125f * LOG2E;
constexpr float XSCALE = 0.0625f * LOG2E;

constexpr size_t O_Y = 0;
constexpr size_t O_DKP = (size_t)R * DM;
constexpr size_t O_DVP = O_DKP + (size_t)DEPTH * RP * 512;
constexpr size_t O_MKP = O_DVP + (size_t)DEPTH * RP * 512;
constexpr size_t O_MVP = O_MKP + (size_t)DEPTH * MEMR * DM;
constexpr size_t O_FCP = O_MVP + (size_t)DEPTH * MEMR * DM;
constexpr size_t O_DKS = O_FCP + (size_t)DEPTH * NBATCH * 2 * DFF;
constexpr size_t O_DVS = O_DKS + (size_t)DEPTH * RS * 512;
constexpr size_t O_GVS = O_DVS + (size_t)DEPTH * RS * 512;
constexpr size_t O_FCS = O_GVS + (size_t)DEPTH * RS * 512;
constexpr size_t O_END = O_FCS + (size_t)DEPTH * DB * 2 * DFF;

constexpr size_t MiB = 1u << 20;
constexpr size_t WS_SSQ = 0;
constexpr size_t WS_SSQM = 6 * MiB + MiB / 2;
constexpr size_t WS_BAR = 6 * MiB + MiB / 2 + 65536;
constexpr size_t WS_SSQQ = 6 * MiB + 3 * MiB / 4;
constexpr size_t WS_LSUM = 9 * MiB;
constexpr size_t WS_W = 11 * MiB;
constexpr size_t WS_XB = 137 * MiB;
constexpr size_t WS_MB = 266 * MiB;
constexpr size_t WS_MK = 282 * MiB;
constexpr size_t WS_MVT = 298 * MiB;
constexpr size_t WS_A = 314 * MiB;
constexpr size_t WS_Z = WS_A;
constexpr size_t WS_P = WS_A;
constexpr size_t WS_H = WS_A + 322 * MiB;
constexpr size_t WS_Q = WS_A + 451 * MiB;
constexpr size_t WS_VT = WS_Q;
constexpr size_t WS_A2 = WS_A;
constexpr size_t WS_GS = WS_A + 451 * MiB;
constexpr size_t WS_US = WS_A + 474 * MiB;
constexpr size_t WS_SG = WS_A + 486 * MiB;
constexpr size_t WS_END = WS_A + 580 * MiB;
static_assert((size_t)R * INC * 2 <= 322 * MiB && (size_t)R * DM * 2 <= 129 * MiB && (size_t)R * DFF * 2 <= 451 * MiB && (size_t)(RP / 64) * 4 * DFF * 2 <= 23 * MiB && (size_t)(RP / 64) * 2 * DFF * 2 <= 12 * MiB && (size_t)RS * UPC * 2 <= 3 * MiB, "region A map");
static_assert((size_t)DEPTH * 3 * R * 8 <= WS_SSQM && WS_SSQM + MEMR * 4 <= WS_SSQQ && WS_SSQQ + (size_t)R * 32 <= WS_LSUM && WS_LSUM + (size_t)RP * 32 <= WS_W, "ctl map");
constexpr size_t WL_IN = 0, WL_OUT = WL_IN + (size_t)INC * DM, WL_Q = WL_OUT + (size_t)DM * DM, WL_K = WL_Q + (size_t)DM * DM, WL_V = WL_K + (size_t)DM * DM,
                 WL_O = WL_V + (size_t)DM * DM, WL_UP = WL_O + (size_t)DM * DM, WL_DN = WL_UP + (size_t)UPC * DM, WL_STRIDE = WL_DN + (size_t)DM * DFF;
static_assert(WS_W + DEPTH * WL_STRIDE * 2 <= WS_XB, "weights map");

constexpr int LDS_BYTES = 147456;

struct Params {
    const float* in[34];
    float* out;
    unsigned char* ws;
};
typedef const Params __attribute__((address_space(4)))* KParams;
DI KParams kparams() { KParams kp = (KParams)__builtin_amdgcn_kernarg_segment_ptr(); asm volatile("" : "+s"(kp)); return kp; }

DI unsigned pk2(float lo, float hi) { f32x2 v = {lo, hi}; bf16x2_t b = __builtin_convertvector(v, bf16x2_t); return __builtin_bit_cast(unsigned, b); }
DI float bflo(unsigned w) { return __uint_as_float(w << 16); }
DI float bfhi(unsigned w) { return __uint_as_float(w & 0xffff0000u); }
DI float wave_sum(float v) {
#pragma unroll
    for (int o = 1; o < 64; o <<= 1) v += __shfl_xor(v, o);
    return v;
}
DI float wave_max(float v) {
#pragma unroll
    for (int o = 1; o < 64; o <<= 1) v = fmaxf(v, __shfl_xor(v, o));
    return v;
}
DI float gelu_t(float x) {
    const float u = 0.7978845608028654f * (x + 0.044715f * x * x * x);
    const float e = __builtin_amdgcn_exp2f(-2.f * LOG2E * u);
    return x * __builtin_amdgcn_rcpf(1.f + e);
}
DI float silu_f(float x) { return x * __builtin_amdgcn_rcpf(1.f + __builtin_amdgcn_exp2f(-LOG2E * x)); }
DI float rstd_of(float ssq, float inv_n) { return 1.0f / sqrtf(ssq * inv_n + EPS); }
typedef unsigned long long acc_t;
constexpr float SSQ_SCALE = 1048576.0f, LS_SCALE = 16777216.0f;
DI void acc_add(acc_t* p, float v, float scale) { atomicAdd(p, (acc_t)(v * scale)); }
DI float acc_get(const acc_t* p, float inv_scale) { return (float)(*p) * inv_scale; }
DI float acc_get_i(const acc_t* base, unsigned idx, float inv_scale) { return (float)(*(const acc_t*)((const char*)base + idx * 8u)) * inv_scale; }
DI void unpack8(const u32x4 w, float (&v)[8]) {
    v[0] = bflo(w.x); v[1] = bfhi(w.x); v[2] = bflo(w.y); v[3] = bfhi(w.y); v[4] = bflo(w.z); v[5] = bfhi(w.z); v[6] = bflo(w.w); v[7] = bfhi(w.w);
}
DI u32x4 pack8(const float (&v)[8]) { u32x4 w; w.x = pk2(v[0], v[1]); w.y = pk2(v[2], v[3]); w.z = pk2(v[4], v[5]); w.w = pk2(v[6], v[7]); return w; }
template <class T> DI T* boff(T* base, unsigned byte_off) { return (T*)((char*)base + byte_off); }
DI float lam_init_of(int l) { return l == 0 ? 0.2f : l == 1 ? 0.35550906759096934f : l == 2 ? 0.4707130183435842f : 0.5560582041556406f; }
namespace pg8 {
constexpr int BM = 256, BK = 64, HALF = 128, HTB = HALF * BK * 2, STAGE_BYTES = 8 * HTB, NXCD = 8, WGM = 8;
DI int lds_byte(int r, int c) { const int st = (r >> 4) * 2 + (c >> 5), rr = r & 15, cc = c & 31, ob = rr * 64 + cc * 2; return st * 1024 + (ob ^ (((ob >> 9) & 1) << 5)); }
DI void stage_rc(int b, int& Rr, int& C) { const int st = b / 1024, sb = b % 1024, swz = sb ^ (((sb >> 9) & 1) << 5); Rr = (st >> 1) * 16 + swz / 64; C = (st & 1) * 32 + (swz % 64) / 2; }
DI int perm32(int rho) { const int n = rho >> 4, i = rho & 15; return 8 * (i >> 2) + 4 * n + (i & 3); }
struct Unit { int pm, pn; };

struct SchedStd {
    int nM, nN, nwg, G, c; const char* A; const char* B; size_t tA, tB;
    DI void init(const bf16_t* A_, int lda, const bf16_t* B_, int ldb, int M, int N, int G_, int c_) { nM = M / BM; nN = N / BM; nwg = nM * nN; G = G_; c = c_; A = (const char*)A_; B = (const char*)B_; tA = (size_t)BM * lda * 2; tB = (size_t)BM * ldb * 2; }
    DI bool next(int i, Unit& u) const {
        const long L = (long)i * G + c; if (c < 0 || L >= nwg) return false;
        int wgid = (int)L; { const int q = nwg / NXCD, r = nwg % NXCD, xcd = wgid % NXCD, off = wgid / NXCD; wgid = (xcd < r ? xcd * (q + 1) : r * (q + 1) + (xcd - r) * q) + off; }
        const int nig = WGM * nN, gid = wgid / nig, fm = gid * WGM, gsz = (nM - fm) < WGM ? (nM - fm) : WGM;
        u.pm = fm + ((wgid % nig) % gsz); u.pn = (wgid % nig) / gsz; return true;
    }
    DI const char* a_base(const Unit& u) const { return A + (size_t)u.pm * tA; }
    DI const char* b_base(const Unit& u) const { return B + (size_t)u.pn * tB; }
};
struct SchedX {
    int G, c; const char* A; const char* B; size_t bB, hB;
    DI bool next(int i, Unit& u) const { const int L = i * G + c; if (L >= (RP / BM) * 4) return false; u.pm = L >> 2; u.pn = L & 3; return true; }
    DI const char* a_base(const Unit& u) const { return A + ((size_t)u.pm * BM * DM + (size_t)u.pn * 256) * 2; }
    DI const char* b_base(const Unit& u) const { return B + (size_t)(u.pm >> 3) * bB + (size_t)u.pn * hB; }
};

template <class Epi, class Sched>
DI void gemm_phase(LAS unsigned char* lds, const int tid, const int K, const int lda, const int ldb, const Sched& S, const Epi& E) {
    const int wid = __builtin_amdgcn_readfirstlane(tid >> 6), lane = tid & 63, wr = wid >> 2, wc = wid & 3, fr = lane & 15, fq = lane >> 4;
    const int nt = K / BK;
    unsigned voffA[2], voffB[2];
#pragma unroll
    for (int i = 0; i < 2; ++i) { int Rr, C; stage_rc(tid * 16 + i * 8192, Rr, C); const int Rb = Epi::PERM ? ((Rr & ~31) + perm32(Rr & 31)) : Rr;
        voffA[i] = (unsigned)(Rr * lda + C) * 2u; voffB[i] = (unsigned)(Rb * ldb + C) * 2u; }
    const size_t kstep = (size_t)(BK * 2);
    const size_t hA = (size_t)HALF * lda * 2, hB = (size_t)HALF * ldb * 2;
    const unsigned ldsw = (unsigned)wid * 1024u;
    const int aoff = lds_byte(wr * 64 + fr, fq * 8), boff = lds_byte(wc * 32 + fr, fq * 8);
#define PG8_SA(b, h) (((b) * 2 + (h)) * HTB)
#define PG8_SB(b, h) ((4 + (b) * 2 + (h)) * HTB)
#define PG8_STAGE(bufoff, gbase, voff) do { _Pragma("unroll") for (int _i = 0; _i < 2; ++_i) \
        __builtin_amdgcn_global_load_lds((const unsigned*)((const char*)(gbase) + (voff)[_i]), (LAS unsigned*)(lds + (bufoff) + ldsw + _i * 8192), 16, 0, 0); } while (0)
#define PG8_LDA(dst, b, h) do { _Pragma("unroll") for (int m = 0; m < 4; ++m) _Pragma("unroll") for (int k = 0; k < 2; ++k) dst[m][k] = *(const LAS bf16x8*)(lds + PG8_SA(b, h) + aoff + m * 2048 + k * 1024); } while (0)
#define PG8_LDB(dst, b, h) do { _Pragma("unroll") for (int n = 0; n < 2; ++n) _Pragma("unroll") for (int k = 0; k < 2; ++k) dst[n][k] = *(const LAS bf16x8*)(lds + PG8_SB(b, h) + boff + n * 2048 + k * 1024); } while (0)
#define PG8_MMA(ai, bj, At, Bt) do { __builtin_amdgcn_s_setprio(1); _Pragma("unroll") for (int m = 0; m < 4; ++m) _Pragma("unroll") for (int n = 0; n < 2; ++n) _Pragma("unroll") for (int k = 0; k < 2; ++k) \
        acc[ai][bj][m][n] = __builtin_amdgcn_mfma_f32_16x16x32_bf16(Bt[n][k], At[m][k], acc[ai][bj][m][n], 0, 0, 0); __builtin_amdgcn_s_setprio(0); } while (0)
#define PG8_WAIT_V(n) asm volatile("s_waitcnt vmcnt(" #n ")" ::: "memory")
#define PG8_WAIT_L(n) asm volatile("s_waitcnt lgkmcnt(" #n ")" ::: "memory")
#define PG8_BAR __builtin_amdgcn_s_barrier()
#define PG8_SCHED __builtin_amdgcn_sched_barrier(0)
    Unit cur, nxt; int ui = 0;
    if (!S.next(0, cur)) return;
    f32x4 acc[2][2][4][2];
#pragma unroll
    for (int a = 0; a < 2; ++a)
#pragma unroll
        for (int b = 0; b < 2; ++b)
#pragma unroll
            for (int m = 0; m < 4; ++m)
#pragma unroll
                for (int n = 0; n < 2; ++n) acc[a][b][m][n] = (f32x4){0.f, 0.f, 0.f, 0.f};
    bf16x8 At[4][2], B0[2][2], B1[2][2];
    const char* cA = S.a_base(cur); const char* cB = S.b_base(cur);
    PG8_STAGE(PG8_SB(0, 0), cB, voffB); PG8_STAGE(PG8_SB(0, 1), cB + hB, voffB); PG8_STAGE(PG8_SA(0, 0), cA, voffA); PG8_STAGE(PG8_SA(0, 1), cA + hA, voffA);
    if (wr == 1) PG8_BAR;
    PG8_WAIT_V(2); PG8_BAR;
    PG8_STAGE(PG8_SB(1, 0), cB + kstep, voffB); PG8_STAGE(PG8_SA(1, 0), cA + kstep, voffA); PG8_STAGE(PG8_SB(1, 1), cB + hB + kstep, voffB);
    PG8_WAIT_V(6); PG8_BAR;
    for (;;) {
        const bool has_next = S.next(ui + 1, nxt);
        const char* nA = has_next ? S.a_base(nxt) : cA; const char* nB = has_next ? S.b_base(nxt) : cB;
#pragma unroll 1
        for (int t = 0; t < nt; t += 2) {
            const bool last = (t == nt - 2);
            const char* a1 = cA + (size_t)(t + 1) * kstep;
            const char* a2 = last ? nA : cA + (size_t)(t + 2) * kstep; const char* b2 = last ? nB : cB + (size_t)(t + 2) * kstep;
            const char* a3 = a2 + kstep; const char* b3 = b2 + kstep;
            PG8_LDB(B0, 0, 0); PG8_LDB(B1, 0, 1); PG8_SCHED; PG8_LDA(At, 0, 0); PG8_STAGE(PG8_SA(1, 1), a1 + hA, voffA);
            PG8_WAIT_V(8); PG8_WAIT_L(0); PG8_BAR; PG8_MMA(0, 0, At, B0); PG8_MMA(0, 1, At, B1); PG8_BAR; PG8_SCHED;
            PG8_LDA(At, 0, 1); PG8_STAGE(PG8_SB(0, 0), b2, voffB); PG8_STAGE(PG8_SB(0, 1), b2 + hB, voffB); PG8_STAGE(PG8_SA(0, 0), a2, voffA);
            PG8_WAIT_V(8); PG8_WAIT_L(0); PG8_BAR; PG8_MMA(1, 0, At, B0); PG8_MMA(1, 1, At, B1); PG8_BAR; PG8_SCHED;
            PG8_LDB(B0, 1, 0); PG8_LDB(B1, 1, 1); PG8_SCHED; PG8_LDA(At, 1, 0); PG8_STAGE(PG8_SA(0, 1), a2 + hA, voffA);
            PG8_WAIT_V(8); PG8_WAIT_L(0); PG8_BAR; PG8_MMA(0, 0, At, B0); PG8_MMA(0, 1, At, B1); PG8_BAR; PG8_SCHED;
            PG8_LDA(At, 1, 1); PG8_STAGE(PG8_SB(1, 0), b3, voffB); PG8_STAGE(PG8_SB(1, 1), b3 + hB, voffB); PG8_STAGE(PG8_SA(1, 0), a3, voffA);
            PG8_WAIT_V(8); PG8_WAIT_L(0); PG8_BAR; PG8_MMA(1, 0, At, B0); PG8_MMA(1, 1, At, B1); PG8_BAR; PG8_SCHED;
        }
        if (wr == 0) PG8_BAR;
        E(acc, cur, wr, wc, fr, fq);
        if (!has_next) break;
#pragma unroll
        for (int a = 0; a < 2; ++a)
#pragma unroll
            for (int b = 0; b < 2; ++b)
#pragma unroll
                for (int m = 0; m < 4; ++m)
#pragma unroll
                    for (int n = 0; n < 2; ++n) acc[a][b][m][n] = (f32x4){0.f, 0.f, 0.f, 0.f};
        cur = nxt; cA = nA; cB = nB; ++ui;
        if (wr == 1) PG8_BAR;
    }
    PG8_WAIT_V(0);
    PG8_BAR;
#undef PG8_SA
#undef PG8_SB
#undef PG8_STAGE
#undef PG8_LDA
#undef PG8_LDB
#undef PG8_MMA
#undef PG8_WAIT_V
#undef PG8_WAIT_L
#undef PG8_BAR
#undef PG8_SCHED
}

#define EPI_ROWS_BEGIN _Pragma("unroll") for (int ai = 0; ai < 2; ++ai) _Pragma("unroll") for (int m = 0; m < 4; ++m) { const int row = u.pm * BM + ai * HALF + wr * 64 + m * 16 + fr;
#define EPI_ROWS_END }


DI void store_pair_transposed(bf16_t* Tcol0, int pitch, int r, int fr, unsigned w01, unsigned w23, unsigned w45, unsigned w67) {
    const bool odd = fr & 1;
    const unsigned s0 = odd ? w01 : w45, s1 = odd ? w23 : w67;
    const unsigned r0 = __shfl_xor(s0, 1), r1 = __shfl_xor(s1, 1);
    const unsigned X0 = odd ? r0 : w01, X1 = odd ? r1 : w23, Y0 = odd ? w45 : r0, Y1 = odd ? w67 : r1;
    bf16_t* base = Tcol0 + (size_t)(odd ? 4 : 0) * pitch + (r & ~1);
    *(unsigned*)(base) = (X0 & 0xffffu) | (Y0 << 16);
    *(unsigned*)(base + pitch) = (X0 >> 16) | (Y0 & 0xffff0000u);
    *(unsigned*)(base + 2 * (size_t)pitch) = (X1 & 0xffffu) | (Y1 << 16);
    *(unsigned*)(base + 3 * (size_t)pitch) = (X1 >> 16) | (Y1 & 0xffff0000u);
}
struct EpiIn {
    static constexpr bool PERM = true;
    bf16_t* Z; const acc_t* ssq; float* dvp; float* dvs; bf16_t* VT;
    DI void operator()(const f32x4 (&acc)[2][2][4][2], const Unit& u, int wr, int wc, int fr, int fq) const {
        const int colb = u.pn * BM + wc * 32 + 8 * fq;
        EPI_ROWS_BEGIN
            const float rs = rstd_of(acc_get(ssq + row, 1.0f / SSQ_SCALE), 1.0f / DM);
#pragma unroll
            for (int bj = 0; bj < 2; ++bj) { const int col = colb + bj * HALF; f32x4 v0 = acc[ai][bj][m][0] * rs, v1 = acc[ai][bj][m][1] * rs;
                if (u.pn == 4 || u.pn == 5) { float* dst = (row < RP ? dvp + (size_t)row * 512 : dvs + (size_t)(row - RP) * 512) + (col - 1024); *(f32x4*)dst = v0; *(f32x4*)(dst + 4) = v1;
                    if (u.pm < RP / BM) store_pair_transposed(VT + ((size_t)(row >> 11) * 512 + (col - 1024)) * SEQ, SEQ, row & (SEQ - 1), fr, pk2(v0[0], v0[1]), pk2(v0[2], v0[3]), pk2(v1[0], v1[1]), pk2(v1[2], v1[3])); }
                else { if (u.pn >= 6) {
#pragma unroll
                        for (int j = 0; j < 4; ++j) { v0[j] = gelu_t(v0[j]); v1[j] = gelu_t(v1[j]); } }
                    u32x4 w; w.x = pk2(v0[0], v0[1]); w.y = pk2(v0[2], v0[3]); w.z = pk2(v1[0], v1[1]); w.w = pk2(v1[2], v1[3]);
                    *(u32x4*)(Z + (size_t)row * INC + col) = w; } }
        EPI_ROWS_END
    }
};
struct EpiKV {
    static constexpr bool PERM = true;
    bf16_t* MK; const float* ssq; float* mvp; bf16_t* MVT;
    DI void operator()(const f32x4 (&acc)[2][2][4][2], const Unit& u, int wr, int wc, int fr, int fq) const {
        const int colb = (u.pn & 3) * BM + wc * 32 + 8 * fq;
        EPI_ROWS_BEGIN
            const float rs = rstd_of(ssq[row], 1.0f / DM);
#pragma unroll
            for (int bj = 0; bj < 2; ++bj) { const int col = colb + bj * HALF; const f32x4 v0 = acc[ai][bj][m][0] * rs, v1 = acc[ai][bj][m][1] * rs;
                if (u.pn >= 4) { float* dst = mvp + (size_t)row * DM + col; *(f32x4*)dst = v0; *(f32x4*)(dst + 4) = v1;
                    store_pair_transposed(MVT + ((size_t)(row >> 8) * DM + col) * 256, 256, row & 255, fr, pk2(v0[0], v0[1]), pk2(v0[2], v0[3]), pk2(v1[0], v1[1]), pk2(v1[2], v1[3])); }
                else { u32x4 w; w.x = pk2(v0[0], v0[1]); w.y = pk2(v0[2], v0[3]); w.z = pk2(v1[0], v1[1]); w.w = pk2(v1[2], v1[3]); *(u32x4*)(MK + (size_t)row * DM + col) = w; } }
        EPI_ROWS_END
    }
};
struct EpiRes {
    static constexpr bool PERM = true;
    float* Y; bf16_t* XB; acc_t* ssq_next;
    DI void operator()(const f32x4 (&acc)[2][2][4][2], const Unit& u, int wr, int wc, int fr, int fq) const {
        const int colb = u.pn * BM + wc * 32 + 8 * fq;
        EPI_ROWS_BEGIN
            float ss = 0.f;
#pragma unroll
            for (int bj = 0; bj < 2; ++bj) { const int col = colb + bj * HALF; bf16_t* xp = XB + (size_t)row * DM + col;
                float xv[8]; unpack8(*(const u32x4*)xp, xv);
                const f32x4 x0 = (f32x4){xv[0], xv[1], xv[2], xv[3]} + acc[ai][bj][m][0], x1 = (f32x4){xv[4], xv[5], xv[6], xv[7]} + acc[ai][bj][m][1];
                if (Y != nullptr) { float* yp = Y + (size_t)row * DM + col; *(f32x4*)yp = x0; *(f32x4*)(yp + 4) = x1; }
                u32x4 w; w.x = pk2(x0[0], x0[1]); w.y = pk2(x0[2], x0[3]); w.z = pk2(x1[0], x1[1]); w.w = pk2(x1[2], x1[3]); *(u32x4*)xp = w;
                ss += (x0[0] * x0[0] + x0[1] * x0[1]) + (x0[2] * x0[2] + x0[3] * x0[3]) + (x1[0] * x1[0] + x1[1] * x1[1]) + (x1[2] * x1[2] + x1[3] * x1[3]); }
            ss += __shfl_xor(ss, 16); ss += __shfl_xor(ss, 32);
            if (ssq_next != nullptr && fq == 0) acc_add(ssq_next + row, ss, SSQ_SCALE);
        EPI_ROWS_END
    }
};

struct EpiQ {
    static constexpr bool PERM = true;
    bf16_t* Q; const acc_t* ssq; acc_t* ssqq;
    DI void operator()(const f32x4 (&acc)[2][2][4][2], const Unit& u, int wr, int wc, int fr, int fq) const {
        const int colb = u.pn * BM + wc * 32 + 8 * fq;
        EPI_ROWS_BEGIN
            const float rs = rstd_of(acc_get(ssq + row, 1.0f / SSQ_SCALE), 1.0f / DM); float ss = 0.f;
#pragma unroll
            for (int bj = 0; bj < 2; ++bj) { const int col = colb + bj * HALF; const f32x4 v0 = acc[ai][bj][m][0] * rs, v1 = acc[ai][bj][m][1] * rs;
                u32x4 w; w.x = pk2(v0[0], v0[1]); w.y = pk2(v0[2], v0[3]); w.z = pk2(v1[0], v1[1]); w.w = pk2(v1[2], v1[3]); *(u32x4*)(Q + (size_t)row * DM + col) = w;
                ss += (v0[0] * v0[0] + v0[1] * v0[1]) + (v0[2] * v0[2] + v0[3] * v0[3]) + (v1[0] * v1[0] + v1[1] * v1[1]) + (v1[2] * v1[2] + v1[3] * v1[3]); }
            ss += __shfl_xor(ss, 16); ss += __shfl_xor(ss, 32);
            if (fq == 0) acc_add(ssqq + (size_t)row * 4 + u.pn, ss, SSQ_SCALE);
        EPI_ROWS_END
    }
};
struct EpiS {
    static constexpr bool PERM = true;
    bf16_t* P; const acc_t* ssqq; acc_t* lsum;
    DI void operator()(const f32x4 (&acc)[2][2][4][2], const Unit& u, int wr, int wc, int fr, int fq) const {
        const int colb = u.pn * BM + wc * 32 + 8 * fq;
        EPI_ROWS_BEGIN
            const float rs = rstd_of(acc_get(ssqq + (size_t)row * 4 + u.pn, 1.0f / SSQ_SCALE), 1.0f / 256.f) * XSCALE; float ss = 0.f;
#pragma unroll
            for (int bj = 0; bj < 2; ++bj) { const int col = colb + bj * HALF; f32x4 v0 = acc[ai][bj][m][0] * rs, v1 = acc[ai][bj][m][1] * rs;
#pragma unroll
                for (int j = 0; j < 4; ++j) { v0[j] = __builtin_amdgcn_exp2f(v0[j]); v1[j] = __builtin_amdgcn_exp2f(v1[j]); }
                u32x4 w; w.x = pk2(v0[0], v0[1]); w.y = pk2(v0[2], v0[3]); w.z = pk2(v1[0], v1[1]); w.w = pk2(v1[2], v1[3]); *(u32x4*)(P + (size_t)row * DM + col) = w;
                ss += (v0[0] + v0[1]) + (v0[2] + v0[3]) + (v1[0] + v1[1]) + (v1[2] + v1[3]); }
            ss += __shfl_xor(ss, 16); ss += __shfl_xor(ss, 32);
            if (fq == 0) acc_add(lsum + (size_t)row * 4 + u.pn, ss, LS_SCALE);
        EPI_ROWS_END
    }
};
struct EpiPV {
    static constexpr bool PERM = true;
    bf16_t* H; const acc_t* lsum;
    DI void operator()(const f32x4 (&acc)[2][2][4][2], const Unit& u, int wr, int wc, int fr, int fq) const {
        const int colb = u.pn * BM + wc * 32 + 8 * fq;
        EPI_ROWS_BEGIN
            const float rs = 1.0f / acc_get(lsum + (size_t)row * 4 + u.pn, 1.0f / LS_SCALE);
#pragma unroll
            for (int bj = 0; bj < 2; ++bj) { const int col = colb + bj * HALF; const f32x4 v0 = acc[ai][bj][m][0] * rs, v1 = acc[ai][bj][m][1] * rs;
                u32x4 w; w.x = pk2(v0[0], v0[1]); w.y = pk2(v0[2], v0[3]); w.z = pk2(v1[0], v1[1]); w.w = pk2(v1[2], v1[3]); *(u32x4*)(H + (size_t)row * DM + col) = w; }
        EPI_ROWS_END
    }
};
struct EpiUpAct {
    static constexpr bool PERM = true;
    bf16_t* A2; const acc_t* ssq; bf16_t* GS; bf16_t* US; bf16_t* SG; const float* cw; const float* cb; float* fcp; float* fcs;
    DI void operator()(const f32x4 (&acc)[2][2][4][2], const Unit& u, int wr, int wc, int fr, int fq) const {
        const int c8 = u.pn * HALF + wc * 32 + 8 * fq;
        if (u.pm == RP / BM) {
            Unit uu = u; asm volatile("" : "+s"(uu.pm));
            const Unit& u = uu;
            EPI_ROWS_BEGIN
                const float rs = rstd_of(acc_get(ssq + row, 1.0f / SSQ_SCALE), 1.0f / DM); const int sr = row - RP;
#pragma unroll
                for (int bj = 0; bj < 2; ++bj) { const f32x4 v0 = acc[ai][bj][m][0] * rs, v1 = acc[ai][bj][m][1] * rs;
                    u32x4 w; w.x = pk2(v0[0], v0[1]); w.y = pk2(v0[2], v0[3]); w.z = pk2(v1[0], v1[1]); w.w = pk2(v1[2], v1[3]); *(u32x4*)(SG + (size_t)sr * UPC + bj * DFF + c8) = w;
                    if (bj == 0 && (sr & 31) >= 30) { float* dst = fcs + ((size_t)(sr >> 5) * 2 + ((sr & 31) - 30)) * DFF + c8; *(f32x4*)dst = v0; *(f32x4*)(dst + 4) = v1; } }
            EPI_ROWS_END
            return;
        }
        const int src1 = (fq << 4) | ((fr + 15) & 15), src2 = (fq << 4) | ((fr + 14) & 15);
#pragma unroll
        for (int n = 0; n < 2; ++n) {
            const int c4 = c8 + 4 * n;
            const f32x4 w0 = *(const f32x4*)(cw + c4), w1 = *(const f32x4*)(cw + DFF + c4), w2 = *(const f32x4*)(cw + 2 * DFF + c4), cbv = *(const f32x4*)(cb + c4);
#pragma unroll
            for (int ai = 0; ai < 2; ++ai) {
                f32x4 pg = {0.f, 0.f, 0.f, 0.f};
#pragma unroll
                for (int m = 0; m < 4; ++m) { const int row = u.pm * BM + ai * HALF + wr * 64 + m * 16 + fr;
                    const float rs = rstd_of(acc_get_i(ssq, (unsigned)row, 1.0f / SSQ_SCALE), 1.0f / DM);
                    const f32x4 g = acc[ai][0][m][n] * rs, up = acc[ai][1][m][n] * rs;
                    f32x4 a;
#pragma unroll
                    for (int j = 0; j < 4; ++j) { const float s1 = __shfl(fr == 15 ? pg[j] : g[j], src1), s2 = __shfl(fr >= 14 ? pg[j] : g[j], src2);
                        a[j] = silu_f(cbv[j] + w0[j] * s2 + w1[j] * s1 + w2[j] * g[j]) * up[j]; }
                    u32x2 gw; gw.x = pk2(g[0], g[1]); gw.y = pk2(g[2], g[3]);
                    if (m == 0 && fr < 2) {
                        *boff((u32x2*)GS, (unsigned)(((row >> 6) * 4 + 2 + fr) * DFF + c4) * 2u) = gw;
                        u32x2 uw; uw.x = pk2(up[0], up[1]); uw.y = pk2(up[2], up[3]); *boff((u32x2*)US, (unsigned)(((row >> 6) * 2 + fr) * DFF + c4) * 2u) = uw;
                    } else { u32x2 w; w.x = pk2(a[0], a[1]); w.y = pk2(a[2], a[3]); *boff((u32x2*)A2, (unsigned)(row * DFF + c4) * 2u) = w; }
                    if (m == 3 && fr >= 14) {
                        *boff((u32x2*)GS, (unsigned)(((row >> 6) * 4 + (fr - 14)) * DFF + c4) * 2u) = gw;
                        if ((row & (SEQ - 1)) >= SEQ - 2) *boff((f32x4*)fcp, (unsigned)(((row >> 11) * 2 + ((row & (SEQ - 1)) - (SEQ - 2))) * DFF + c4) * 4u) = g;
                    }
                    pg = g;
                    asm volatile("" ::: "memory");
                }
            }
        }
    }
};

}
template <bool UPMAP = false>
DI void transpose_item(const float* W, int K, int N, bf16_t* WT, const float* gain, LAS float* scr, int item, int lane) {
    const int nblk = N / 32, kb = item / nblk, nb = item % nblk, k0 = 64 * kb, n0 = 32 * nb;
    const int r0 = !UPMAP ? n0 : (n0 < DFF ? ((n0 >> 7) << 8) + (n0 & 127) : (((n0 - DFF) >> 7) << 8) + 128 + ((n0 - DFF) & 127));
#pragma unroll
    for (int i = 0; i < 32; ++i) { const int kk = 2 * i + (lane >> 5); float v = W[(size_t)(k0 + kk) * N + n0 + (lane & 31)]; if (gain) v *= gain[k0 + kk]; scr[kk * 33 + (lane & 31)] = v; }
    asm volatile("s_waitcnt lgkmcnt(0)" ::: "memory");
    const int c = lane & 7;
#pragma unroll
    for (int j = 0; j < 4; ++j) { const int n = (lane >> 3) + 8 * j; const LAS float* s = scr + (8 * c) * 33 + n;
        u32x4 o; o.x = pk2(s[0 * 33], s[1 * 33]); o.y = pk2(s[2 * 33], s[3 * 33]); o.z = pk2(s[4 * 33], s[5 * 33]); o.w = pk2(s[6 * 33], s[7 * 33]);
        *(u32x4*)(WT + (size_t)(r0 + n) * K + k0 + 8 * c) = o; }
    asm volatile("s_waitcnt lgkmcnt(0)" ::: "memory");
}
template <bool UPMAP = false>
DI void convert_matrix(const float* W, int K, int N, bf16_t* WT, const float* gain, LAS float* scr, int gw, int ngw, int lane) {
    const int nitems = (K / 64) * (N / 32);
    for (int it = gw; it < nitems; it += ngw) transpose_item<UPMAP>(W, K, N, WT, gain, scr, it, lane);
}

DI void convert_layer_weights(int l, int part, LAS float* scr, int gw, int ngw, int lane) {
    bf16_t* wl = (bf16_t*)(kparams()->ws + WS_W) + (size_t)l * WL_STRIDE;
    if (part < 0 || part == 0) {
        { KParams p = kparams(); convert_matrix(p->in[9] + (size_t)l * DM * INC, DM, INC, wl + WL_IN, p->in[8] + l * DM, scr, gw, ngw, lane); }
        { KParams p = kparams(); convert_matrix(p->in[20] + (size_t)l * DM * DM, DM, DM, wl + WL_OUT, nullptr, scr, gw, ngw, lane); } }
    if (part < 0 || part == 1) {
        { KParams p = kparams(); convert_matrix(p->in[23] + (size_t)l * DM * DM, DM, DM, wl + WL_Q, p->in[21] + l * DM, scr, gw, ngw, lane); }
        { KParams p = kparams(); convert_matrix(p->in[24] + (size_t)l * DM * DM, DM, DM, wl + WL_K, p->in[22] + l * DM, scr, gw, ngw, lane); }
        { KParams p = kparams(); convert_matrix(p->in[25] + (size_t)l * DM * DM, DM, DM, wl + WL_V, p->in[22] + l * DM, scr, gw, ngw, lane); }
        { KParams p = kparams(); convert_matrix(p->in[26] + (size_t)l * DM * DM, DM, DM, wl + WL_O, nullptr, scr, gw, ngw, lane); } }
    if (part < 0 || part == 2) {
        { KParams p = kparams(); convert_matrix<true>(p->in[30] + (size_t)l * DM * UPC, DM, UPC, wl + WL_UP, p->in[29] + l * DM, scr, gw, ngw, lane); }
        { KParams p = kparams(); convert_matrix(p->in[33] + (size_t)l * DFF * DM, DFF, DM, wl + WL_DN, nullptr, scr, gw, ngw, lane); } }
}
DI void phase_prologue(LAS unsigned char* lds, int gw, int ngw, int wid, int lane) {
    LAS float* scr = (LAS float*)(lds + wid * 16384);
    convert_layer_weights(0, -1, scr, gw, ngw, lane);
    KParams p = kparams();
    acc_t* ssq = (acc_t*)(p->ws + WS_SSQ); bf16_t* XB = (bf16_t*)(p->ws + WS_XB);
    const float* xp = p->in[0]; const float* xs = p->in[1];
    for (int row0 = gw; row0 < R; row0 += 4 * ngw) {
        f32x4 v[4][4];
#pragma unroll
        for (int i = 0; i < 4; ++i) { const int row = row0 + i * ngw; if (row < R) { const float* src = row < RP ? xp + (size_t)row * DM : xs + (size_t)(row - RP) * DM;
#pragma unroll
            for (int j = 0; j < 4; ++j) v[i][j] = *(const f32x4*)(src + 4 * lane + 256 * j); } }
#pragma unroll
        for (int i = 0; i < 4; ++i) { const int row = row0 + i * ngw; if (row < R) { float ss = 0.f;
#pragma unroll
            for (int j = 0; j < 4; ++j) { const f32x4 x = v[i][j]; u32x2 w; w.x = pk2(x[0], x[1]); w.y = pk2(x[2], x[3]); *(u32x2*)(XB + (size_t)row * DM + 4 * lane + 256 * j) = w;
                ss += (x[0] * x[0] + x[1] * x[1]) + (x[2] * x[2] + x[3] * x[3]); }
            ss = wave_sum(ss); if (lane == 0) ssq[row] = (acc_t)(ss * SSQ_SCALE); } }
    }
    float* ssqm = (float*)(p->ws + WS_SSQM); bf16_t* MB = (bf16_t*)(p->ws + WS_MB);
    for (int row = gw; row < MEMR; row += ngw) {
        const float* src = p->in[7] + (size_t)row * DM; float ss = 0.f;
#pragma unroll
        for (int j = 0; j < 4; ++j) { const f32x4 v = *(const f32x4*)(src + 4 * lane + 256 * j);
            u32x2 w; w.x = pk2(v[0], v[1]); w.y = pk2(v[2], v[3]); *(u32x2*)(MB + (size_t)row * DM + 4 * lane + 256 * j) = w;
            ss += (v[0] * v[0] + v[1] * v[1]) + (v[2] * v[2] + v[3] * v[3]); }
        ss = wave_sum(ss); if (lane == 0) ssqm[row] = ss;
    }
    for (int i = R + gw * 64 + lane; i < DEPTH * 3 * R; i += ngw * 64) ssq[i] = 0ull;
}

DI void qk_post_row(bf16_t* Z, int row, const u32x4 w0, const u32x4 w1, const float* qg, const float* kg, float* dkp, float* dks, int lane) {
    bf16_t* ptr = Z + (size_t)row * INC + lane * 16;
    float a[8], b[8]; unpack8(w0, a); unpack8(w1, b);
    float ss = 0.f;
#pragma unroll
    for (int i = 0; i < 8; ++i) ss += a[i] * a[i] + b[i] * b[i];
    ss += __shfl_xor(ss, 1); ss += __shfl_xor(ss, 2);
    const float rs = rstd_of(ss, 1.0f / 64.f);
    const bool isq = lane < 32;
    const float* g = (isq ? qg : kg) + (lane & 3) * 16;
#pragma unroll
    for (int i = 0; i < 8; ++i) { a[i] *= rs * g[i]; b[i] *= rs * g[8 + i]; }
    const int pos = row < RP ? (row & (SEQ - 1)) : PAST + ((row - RP) & (DSEQ - 1));
    if ((lane & 3) == 0) {
        const float fp = (float)pos;
        const float hi[8] = {1.5905761719e-01f, 3.0853271484e-02f, 5.9814453125e-03f, 1.1606216431e-03f, 2.2506713867e-04f, 4.3630599976e-05f, 8.4638595581e-06f, 1.6409903765e-06f};
        const float lo[8] = {9.7325901152e-05f, 1.0491919966e-05f, 3.7404001887e-06f, 4.1998173828e-08f, 1.1940367806e-08f, 1.7352817849e-08f, 4.7125015001e-10f, 4.3588632703e-10f};
#pragma unroll
        for (int i = 0; i < 8; ++i) {
            float t = fp * hi[i]; t = t - rintf(t); t += fp * lo[i];
            const float sn = __builtin_amdgcn_sinf(t), cs = __builtin_amdgcn_cosf(t);
            const float x1 = a[i], x2 = b[i]; a[i] = x1 * cs - x2 * sn; b[i] = x2 * cs + x1 * sn; }
    }
    if (!isq) {
        float* dst = (row < RP ? dkp + (size_t)row * 512 : dks + (size_t)(row - RP) * 512) + (lane - 32) * 16;
        *(f32x4*)dst = (f32x4){a[0], a[1], a[2], a[3]}; *(f32x4*)(dst + 4) = (f32x4){a[4], a[5], a[6], a[7]};
        *(f32x4*)(dst + 8) = (f32x4){b[0], b[1], b[2], b[3]}; *(f32x4*)(dst + 12) = (f32x4){b[4], b[5], b[6], b[7]};
    } else {
#pragma unroll
        for (int i = 0; i < 8; ++i) { a[i] *= QSCALE; b[i] *= QSCALE; }
    }
    *(u32x4*)ptr = pack8(a); *(u32x4*)(ptr + 8) = pack8(b);
}
DI void qk_post_rows(bf16_t* Z, int gw, int ngw, const float* qg, const float* kg, float* dkp, float* dks, int lane) {
    for (int row = gw; row < R; row += 4 * ngw) {
        u32x4 w0[4], w1[4];
#pragma unroll
        for (int i = 0; i < 4; ++i) { const int r = row + i * ngw; if (r < R) { const bf16_t* ptr = Z + (size_t)r * INC + lane * 16; w0[i] = *(const u32x4*)ptr; w1[i] = *(const u32x4*)(ptr + 8); } }
#pragma unroll
        for (int i = 0; i < 4; ++i) { const int r = row + i * ngw; if (r < R) qk_post_row(Z, r, w0[i], w1[i], qg, kg, dkp, dks, lane); }
    }
}
DI void memk_post_row(bf16_t* MK, int row, const float* xkg, const float* xqg, float* mkp, int lane) {
    bf16_t* ptr = MK + (size_t)row * DM + lane * 16;
    const u32x4 w0 = *(const u32x4*)ptr, w1 = *(const u32x4*)(ptr + 8);
    float a[8], b[8]; unpack8(w0, a); unpack8(w1, b);
    float ss = 0.f;
#pragma unroll
    for (int i = 0; i < 8; ++i) ss += a[i] * a[i] + b[i] * b[i];
    ss += __shfl_xor(ss, 1); ss += __shfl_xor(ss, 2); ss += __shfl_xor(ss, 4); ss += __shfl_xor(ss, 8);
    const float rs = rstd_of(ss, 1.0f / 256.f);
    const int d0 = (lane & 15) * 16;
#pragma unroll
    for (int i = 0; i < 8; ++i) { a[i] *= rs * xkg[d0 + i]; b[i] *= rs * xkg[d0 + 8 + i]; }
    float* dst = mkp + (size_t)row * DM + lane * 16;
    *(f32x4*)dst = (f32x4){a[0], a[1], a[2], a[3]}; *(f32x4*)(dst + 4) = (f32x4){a[4], a[5], a[6], a[7]};
    *(f32x4*)(dst + 8) = (f32x4){b[0], b[1], b[2], b[3]}; *(f32x4*)(dst + 12) = (f32x4){b[4], b[5], b[6], b[7]};
#pragma unroll
    for (int i = 0; i < 8; ++i) { a[i] *= xqg[d0 + i]; b[i] *= xqg[d0 + 8 + i]; }
    *(u32x4*)ptr = pack8(a); *(u32x4*)(ptr + 8) = pack8(b);
}

#define MFMA32(a, b, c) __builtin_amdgcn_mfma_f32_32x32x16_bf16((a), (b), (c), 0, 0, 0)
DI int crow(int r, int hi) { return (r & 3) + 8 * (r >> 2) + 4 * hi; }

DI void gate_unit(int un, int& cached_g, const bf16_t* Z, bf16_t* H, const float* Wsl, const float* gmb, const float* gmg, LAS unsigned char* lds, int tid, int wid, int lane) {
    const int b = un >> 6, n = (un >> 2) & 15, g = un & 3, row0 = b * SEQ + n * 128;
    LAS unsigned char* Ws = lds; LAS unsigned char* Gt = lds + 128 * 272;
    if (g != cached_g) {
        cached_g = g;
        const float* wsrc = Wsl + (size_t)g * 128 * 128;
#pragma unroll
        for (int i = 0; i < 8; ++i) { const int idx = tid + NTHR * i, t = idx >> 5, s4 = (idx & 31) * 4; f32x4 v = *(const f32x4*)(wsrc + t * 128 + s4);
#pragma unroll
            for (int j = 0; j < 4; ++j) if (s4 + j > t) v[j] = 0.f;
            u32x2 w; w.x = pk2(v[0], v[1]); w.y = pk2(v[2], v[3]); *(LAS u32x2*)(Ws + t * 272 + s4 * 2) = w; }
    }
#pragma unroll
    for (int i = 0; i < 4; ++i) { const int idx = tid + NTHR * i, s = idx >> 4, ch = idx & 15;
        const u32x4 w = *(const u32x4*)(Z + (size_t)(row0 + s) * INC + 2048 + g * 128 + ch * 8); float v[8]; unpack8(w, v);
        float ss = 0.f;
#pragma unroll
        for (int j = 0; j < 8; ++j) ss += v[j] * v[j];
        ss += __shfl_xor(ss, 1); ss += __shfl_xor(ss, 2); ss += __shfl_xor(ss, 4); ss += __shfl_xor(ss, 8);
        const float rs = rstd_of(ss, 1.0f / 128.f);
#pragma unroll
        for (int j = 0; j < 8; j += 2) { const unsigned pw = pk2(v[j] * rs * gmg[ch * 8 + j], v[j + 1] * rs * gmg[ch * 8 + j + 1]);
            *(LAS bf16_t*)(Gt + (ch * 8 + j) * 272 + s * 2) = (bf16_t)(pw & 0xffffu); *(LAS bf16_t*)(Gt + (ch * 8 + j + 1) * 272 + s * 2) = (bf16_t)(pw >> 16); } }
    __syncthreads();
    const int r32 = lane & 31, hi = lane >> 5, tblk = wid & 3, cp = wid >> 2;
    f32x16 acc[2];
#pragma unroll
    for (int i = 0; i < 16; ++i) { acc[0][i] = 0.f; acc[1][i] = 0.f; }
    const int nks = 2 * (tblk + 1);
    for (int ks = 0; ks < nks; ++ks) {
        const bf16x8 bf = *(const LAS bf16x8*)(Ws + (tblk * 32 + r32) * 272 + (ks * 16 + hi * 8) * 2);
#pragma unroll
        for (int cc = 0; cc < 2; ++cc) { const bf16x8 af = *(const LAS bf16x8*)(Gt + ((2 * cp + cc) * 32 + r32) * 272 + (ks * 16 + hi * 8) * 2); acc[cc] = MFMA32(af, bf, acc[cc]); }
    }
    const int t = tblk * 32 + r32, row = row0 + t; const float bias = gmb[g * 128 + t];
#pragma unroll
    for (int cc = 0; cc < 2; ++cc)
#pragma unroll
        for (int rg = 0; rg < 4; ++rg) { const int c0 = (2 * cp + cc) * 32 + 8 * rg + 4 * hi;
            const u32x2 uw = *(const u32x2*)(Z + (size_t)row * INC + 1536 + g * 128 + c0);
            u32x2 o; o.x = pk2(bflo(uw.x) * (acc[cc][4 * rg] + bias), bfhi(uw.x) * (acc[cc][4 * rg + 1] + bias)); o.y = pk2(bflo(uw.y) * (acc[cc][4 * rg + 2] + bias), bfhi(uw.y) * (acc[cc][4 * rg + 3] + bias));
            *(u32x2*)(H + (size_t)row * DM + 512 + g * 128 + c0) = o; }
    __syncthreads();
}
DI void gate_sample_unit(int un, const bf16_t* Z, bf16_t* H, const float* Wsl, const float* gmb, const float* gmg, float* gvs, LAS unsigned char* lds, int tid, int wid, int lane) {
    const int b = un >> 2, g = un & 3, row0 = RP + b * DSEQ;
    LAS float* gvn = (LAS float*)lds;
    for (int s = wid; s < DSEQ; s += NWAVES) {
        const unsigned w = *(const unsigned*)(Z + (size_t)(row0 + s) * INC + 2048 + g * 128 + 2 * lane);
        const float v0 = bflo(w), v1 = bfhi(w); const float ss = wave_sum(v0 * v0 + v1 * v1); const float rs = rstd_of(ss, 1.0f / 128.f);
        const float n0 = v0 * rs * gmg[2 * lane], n1 = v1 * rs * gmg[2 * lane + 1];
        gvn[s * 128 + 2 * lane] = n0; gvn[s * 128 + 2 * lane + 1] = n1;
        *(f32x2*)(gvs + (size_t)(b * DSEQ + s) * 512 + g * 128 + 2 * lane) = (f32x2){n0, n1};
    }
    __syncthreads();
#pragma unroll
    for (int k = 0; k < 8; ++k) { const int idx = tid + NTHR * k, t = idx >> 7, c = idx & 127; float acc = 0.f;
        const float* wr_ = Wsl + (size_t)g * 128 * 128 + t * 128;
        for (int s = 0; s <= t; ++s) acc += wr_[s] * gvn[s * 128 + c];
        const float uu = bflo((unsigned)Z[(size_t)(row0 + t) * INC + 1536 + g * 128 + c]);
        const unsigned pw = pk2(uu * (acc + gmb[g * 128 + t]), 0.f);
        H[(size_t)(row0 + t) * DM + 512 + g * 128 + c] = (bf16_t)(pw & 0xffffu); }
    __syncthreads();
}

DI void diff_attn_unit(int b, int h, int qb, const bf16_t* Z, const bf16_t* VT, bf16_t* H, float lam, const float* subg, float oscale, LAS unsigned char* lds, int wid, int lane) {
    const int r32 = lane & 31, hi = lane >> 5, mp = wid >> 2, wq = wid & 3;
    const int qrow = b * SEQ + qb * 128 + wq * 32 + r32;
    bf16x8 qf[4];
#pragma unroll
    for (int ks = 0; ks < 4; ++ks) qf[ks] = *(const bf16x8*)(Z + (size_t)qrow * INC + h * 128 + mp * 64 + ks * 16 + hi * 8);
    const int ntile = 2 * qb + 2, mylast = 2 * qb + (wq >> 1);
    const bf16_t* kg[2]; const bf16_t* vg[2];
#pragma unroll
    for (int i = 0; i < 2; ++i) { const int q = i * 8 + wid;
        { const int row = 4 * q + (lane >> 4), c = (lane & 15) ^ (row & 15); kg[i] = Z + (size_t)(b * SEQ + row) * INC + 512 + h * 128 + c * 8; }
        { const int row = 8 * q + (lane >> 3), c = (lane & 7) ^ (row & 7); vg[i] = VT + (size_t)((b * 4 + h) * 128 + row) * SEQ + c * 8; } }
#define DA_ISSUE(t, buf) do { _Pragma("unroll") for (int i_ = 0; i_ < 2; ++i_) { \
        __builtin_amdgcn_global_load_lds((const unsigned*)(kg[i_] + (size_t)(t) * 64 * INC), (LAS unsigned*)(lds + (buf) * 32768 + (i_ * 8 + wid) * 1024), 16, 0, 0); \
        __builtin_amdgcn_global_load_lds((const unsigned*)(vg[i_] + (size_t)(t) * 64), (LAS unsigned*)(lds + (buf) * 32768 + 16384 + (i_ * 8 + wid) * 1024), 16, 0, 0); } } while (0)
    f32x16 O[4];
#pragma unroll
    for (int d = 0; d < 4; ++d)
#pragma unroll
        for (int i = 0; i < 16; ++i) O[d][i] = 0.f;
    float ls = 0.f;
    DA_ISSUE(0, 0);
    asm volatile("s_waitcnt vmcnt(0)" ::: "memory"); __syncthreads();
    for (int t = 0; t < ntile; ++t) {
        const int buf = t & 1;
        if (t + 1 < ntile) DA_ISSUE(t + 1, buf ^ 1);
        if (t <= mylast) {
            const LAS unsigned char* kb = lds + buf * 32768; const LAS unsigned char* vb = kb + 16384;
            f32x16 s0, s1;
#pragma unroll
            for (int i = 0; i < 16; ++i) { s0[i] = 0.f; s1[i] = 0.f; }
#pragma unroll
            for (int ks = 0; ks < 4; ++ks) { const int c = mp * 8 + ks * 2 + hi; const int off = r32 * 256 + ((c ^ (r32 & 15)) << 4);
                const bf16x8 a0 = *(const LAS bf16x8*)(kb + off), a1 = *(const LAS bf16x8*)(kb + 8192 + off);
                s0 = MFMA32(a0, qf[ks], s0); s1 = MFMA32(a1, qf[ks], s1); }
#pragma unroll
            for (int i = 0; i < 16; ++i) { s0[i] = __builtin_amdgcn_exp2f(s0[i]); s1[i] = __builtin_amdgcn_exp2f(s1[i]); ls += s0[i] + s1[i]; }
            bf16x8 pb[4]; u32x4 w;
            w.x = pk2(s0[0], s0[1]); w.y = pk2(s0[2], s0[3]); w.z = pk2(s0[4], s0[5]); w.w = pk2(s0[6], s0[7]); pb[0] = __builtin_bit_cast(bf16x8, w);
            w.x = pk2(s0[8], s0[9]); w.y = pk2(s0[10], s0[11]); w.z = pk2(s0[12], s0[13]); w.w = pk2(s0[14], s0[15]); pb[1] = __builtin_bit_cast(bf16x8, w);
            w.x = pk2(s1[0], s1[1]); w.y = pk2(s1[2], s1[3]); w.z = pk2(s1[4], s1[5]); w.w = pk2(s1[6], s1[7]); pb[2] = __builtin_bit_cast(bf16x8, w);
            w.x = pk2(s1[8], s1[9]); w.y = pk2(s1[10], s1[11]); w.z = pk2(s1[12], s1[13]); w.w = pk2(s1[14], s1[15]); pb[3] = __builtin_bit_cast(bf16x8, w);
#pragma unroll
            for (int d = 0; d < 4; ++d)
#pragma unroll
                for (int j = 0; j < 4; ++j) { const int row = 32 * d + r32; const LAS unsigned char* rp = vb + row * 128 + 8 * hi;
                    const u32x2 lo = *(const LAS u32x2*)(rp + (((2 * j) ^ (row & 7)) << 4)), hh = *(const LAS u32x2*)(rp + (((2 * j + 1) ^ (row & 7)) << 4));
                    const u32x4 wv = {lo.x, lo.y, hh.x, hh.y}; const bf16x8 a = __builtin_bit_cast(bf16x8, wv);
                    O[d] = MFMA32(a, pb[j], O[d]); }
        }
        asm volatile("s_waitcnt vmcnt(0)" ::: "memory"); __syncthreads();
    }
#undef DA_ISSUE
    ls += __shfl_xor(ls, 32);
    LAS float* xch = (LAS float*)(lds + wq * 16384);
    if (mp == 1) { const float i1 = lam / ls;
#pragma unroll
        for (int d = 0; d < 4; ++d)
#pragma unroll
            for (int i = 0; i < 16; ++i) xch[(d * 16 + i) * 64 + lane] = O[d][i] * i1; }
    __syncthreads();
    if (mp == 0) { const float i0 = 1.0f / ls; float ss = 0.f;
#pragma unroll
        for (int d = 0; d < 4; ++d)
#pragma unroll
            for (int i = 0; i < 16; ++i) { const float o = O[d][i] * i0 - xch[(d * 16 + i) * 64 + lane]; O[d][i] = o; ss += o * o; }
        ss += __shfl_xor(ss, 32);
        const float rs = rstd_of(ss, 1.0f / 128.f) * oscale;
        bf16_t* hp = H + (size_t)qrow * DM + h * 128;
#pragma unroll
        for (int d = 0; d < 4; ++d)
#pragma unroll
            for (int rg = 0; rg < 4; ++rg) { const int d0 = 32 * d + 8 * rg + 4 * hi; const f32x4 g4 = *(const f32x4*)(subg + d0);
                u32x2 o; o.x = pk2(O[d][4 * rg] * rs * g4[0], O[d][4 * rg + 1] * rs * g4[1]); o.y = pk2(O[d][4 * rg + 2] * rs * g4[2], O[d][4 * rg + 3] * rs * g4[3]);
                *(u32x2*)(hp + d0) = o; } }
    __syncthreads();
}

DI void diff_attn_sample_pair(int it, int hf, int l, const float* cdk, const float* cdv, const float* outp, const bf16_t* Z, bf16_t* H, float lam, const float* subg, float oscale, LAS unsigned char* lds, int wid, int lane) {
    const int srow = it >> 2, h = it & 3, b = srow >> 5;
    LAS float* qs = (LAS float*)(lds + wid * 16384);
    LAS float* ps = qs + 128; LAS float* xst = ps + 2 * 544; LAS float* xacc = xst + 4;
    const LAS float* ost = (const LAS float*)(lds + (wid ^ 1) * 16384) + 128 + 2 * 544; const LAS float* oacc = ost + 4;
    const int NKH = 544, nkl = hf ? 544 : 512, j0g = hf * 512;
    { const unsigned w = *(const unsigned*)(Z + (size_t)(RP + srow) * INC + h * 128 + 2 * lane); qs[2 * lane] = bflo(w); qs[2 * lane + 1] = bfhi(w); }
    asm volatile("s_waitcnt lgkmcnt(0)" ::: "memory");
    const float* ck = cdk + (size_t)(l * DB + b) * PAST * 512 + h * 128;
    const float* nk = outp + O_DKS + (size_t)(l * DB + b) * DSEQ * 512 + h * 128;
    float mx[2] = {-3.0e38f, -3.0e38f};
    for (int jj = lane; jj < nkl; jj += 64) { const int j = j0g + jj;
        const float* kp = j < PAST ? ck + (size_t)j * 512 : nk + (size_t)(j - PAST) * 512;
#pragma unroll
        for (int m = 0; m < 2; ++m) { float dot = 0.f;
#pragma unroll
            for (int d = 0; d < 64; d += 4) { const f32x4 kv = *(const f32x4*)(kp + m * 64 + d); dot += kv[0] * qs[m * 64 + d] + kv[1] * qs[m * 64 + d + 1] + kv[2] * qs[m * 64 + d + 2] + kv[3] * qs[m * 64 + d + 3]; }
            ps[m * NKH + jj] = dot; mx[m] = fmaxf(mx[m], dot); }
    }
    float lsum[2], mm[2];
#pragma unroll
    for (int m = 0; m < 2; ++m) { mm[m] = wave_max(mx[m]); float s = 0.f;
        for (int jj = lane; jj < nkl; jj += 64) { const float e = __builtin_amdgcn_exp2f(ps[m * NKH + jj] - mm[m]); ps[m * NKH + jj] = e; s += e; }
        lsum[m] = wave_sum(s); }
    asm volatile("s_waitcnt lgkmcnt(0)" ::: "memory");
    const float* cv = cdv + (size_t)(l * DB + b) * PAST * 512 + h * 128 + 2 * lane;
    const float* nv = outp + O_DVS + (size_t)(l * DB + b) * DSEQ * 512 + h * 128 + 2 * lane;
    f32x2 a0 = {0.f, 0.f}, a1 = {0.f, 0.f};
#pragma unroll 1
    for (int jb = 0; jb < nkl; jb += 32) {
        const float* vp = (j0g + jb) < PAST ? cv + (size_t)(j0g + jb) * 512 : nv + (size_t)(j0g + jb - PAST) * 512;
        f32x2 v[32];
#pragma unroll
        for (int j = 0; j < 32; ++j) v[j] = *(const f32x2*)(vp + (size_t)j * 512);
#pragma unroll
        for (int j = 0; j < 32; ++j) { a0 += v[j] * ps[jb + j]; a1 += v[j] * ps[NKH + jb + j]; }
    }
    if (lane == 0) { xst[0] = mm[0]; xst[1] = mm[1]; xst[2] = lsum[0]; xst[3] = lsum[1]; }
    *(LAS f32x4*)(xacc + 4 * lane) = (f32x4){a0[0], a0[1], a1[0], a1[1]};
    __syncthreads();
    { const float om0 = ost[0], om1 = ost[1], ol0 = ost[2], ol1 = ost[3]; const f32x4 oa = *(const LAS f32x4*)(oacc + 4 * lane);
      const float M0 = fmaxf(mm[0], om0), M1 = fmaxf(mm[1], om1);
      const float f0 = __builtin_amdgcn_exp2f(mm[0] - M0), g0 = __builtin_amdgcn_exp2f(om0 - M0), f1 = __builtin_amdgcn_exp2f(mm[1] - M1), g1 = __builtin_amdgcn_exp2f(om1 - M1);
      const float l0 = hf ? ol0 * g0 + lsum[0] * f0 : lsum[0] * f0 + ol0 * g0, l1 = hf ? ol1 * g1 + lsum[1] * f1 : lsum[1] * f1 + ol1 * g1;
      const float n00 = hf ? oa[0] * g0 + a0[0] * f0 : a0[0] * f0 + oa[0] * g0, n01 = hf ? oa[1] * g0 + a0[1] * f0 : a0[1] * f0 + oa[1] * g0;
      const float n10 = hf ? oa[2] * g1 + a1[0] * f1 : a1[0] * f1 + oa[2] * g1, n11 = hf ? oa[3] * g1 + a1[1] * f1 : a1[1] * f1 + oa[3] * g1;
      const float i0 = 1.0f / l0, i1 = lam / l1;
      const float o0 = n00 * i0 - n10 * i1, o1 = n01 * i0 - n11 * i1;
      const float ss = wave_sum(o0 * o0 + o1 * o1); const float rs = rstd_of(ss, 1.0f / 128.f) * oscale;
      if (hf == 0) *(unsigned*)(H + (size_t)(RP + srow) * DM + h * 128 + 2 * lane) = pk2(o0 * rs * subg[2 * lane], o1 * rs * subg[2 * lane + 1]); }
}

DI void cross_attn_sample_pair(int it, int hf, int l, const float* cmk, const float* cmv, const bf16_t* Q, const acc_t* ssqq, const float* xqg, bf16_t* H, LAS unsigned char* lds, int wid, int lane) {
    const int srow = it >> 2, h = it & 3, b = srow >> 5, row = RP + srow;
    LAS float* qs = (LAS float*)(lds + wid * 16384);
    LAS float* ps = qs + 256; LAS float* xst = ps + 128; LAS float* xacc = xst + 4;
    const LAS float* ost = (const LAS float*)(lds + (wid ^ 1) * 16384) + 256 + 128; const LAS float* oacc = ost + 4;
    { const u32x2 w = *(const u32x2*)(Q + (size_t)row * DM + h * 256 + 4 * lane); const float rs = rstd_of(acc_get(ssqq + (size_t)row * 4 + h, 1.0f / SSQ_SCALE), 1.0f / 256.f) * XSCALE;
      const f32x4 g4 = *(const f32x4*)(xqg + 4 * lane);
      qs[4 * lane] = bflo(w.x) * rs * g4[0]; qs[4 * lane + 1] = bfhi(w.x) * rs * g4[1]; qs[4 * lane + 2] = bflo(w.y) * rs * g4[2]; qs[4 * lane + 3] = bfhi(w.y) * rs * g4[3]; }
    asm volatile("s_waitcnt lgkmcnt(0)" ::: "memory");
    const float* ck = cmk + ((size_t)(l * DB + b) * 256 + hf * 128) * DM + h * 256;
    float sc[2]; float mx = -3.0e38f;
#pragma unroll
    for (int k = 0; k < 2; ++k) { const float* kp = ck + (size_t)(lane + 64 * k) * DM; float dot = 0.f;
#pragma unroll 1
        for (int d0 = 0; d0 < 256; d0 += 64) { f32x4 kv[16];
#pragma unroll
            for (int d = 0; d < 16; ++d) kv[d] = *(const f32x4*)(kp + d0 + 4 * d);
#pragma unroll
            for (int d = 0; d < 16; ++d) dot += kv[d][0] * qs[d0 + 4 * d] + kv[d][1] * qs[d0 + 4 * d + 1] + kv[d][2] * qs[d0 + 4 * d + 2] + kv[d][3] * qs[d0 + 4 * d + 3]; }
        sc[k] = dot; mx = fmaxf(mx, dot); }
    mx = wave_max(mx); float s = 0.f;
#pragma unroll
    for (int k = 0; k < 2; ++k) { const float e = __builtin_amdgcn_exp2f(sc[k] - mx); ps[lane + 64 * k] = e; s += e; }
    s = wave_sum(s);
    asm volatile("s_waitcnt lgkmcnt(0)" ::: "memory");
    const float* cv = cmv + ((size_t)(l * DB + b) * 256 + hf * 128) * DM + h * 256 + 4 * lane;
    f32x4 acc = {0.f, 0.f, 0.f, 0.f};
#pragma unroll 1
    for (int jb = 0; jb < 128; jb += 16) { f32x4 v[16];
#pragma unroll
        for (int j = 0; j < 16; ++j) v[j] = *(const f32x4*)(cv + (size_t)(jb + j) * DM);
#pragma unroll
        for (int j = 0; j < 16; ++j) acc += v[j] * ps[jb + j]; }
    if (lane == 0) { xst[0] = mx; xst[1] = s; }
    *(LAS f32x4*)(xacc + 4 * lane) = acc;
    __syncthreads();
    { const float om = ost[0], os = ost[1]; const f32x4 oa = *(const LAS f32x4*)(oacc + 4 * lane);
      const float M = fmaxf(mx, om), f = __builtin_amdgcn_exp2f(mx - M), g = __builtin_amdgcn_exp2f(om - M);
      const float lt = hf ? os * g + s * f : s * f + os * g;
      const f32x4 n = hf ? oa * g + acc * f : acc * f + oa * g;
      const float inv = 1.0f / lt;
      if (hf == 0) { u32x2 o; o.x = pk2(n[0] * inv, n[1] * inv); o.y = pk2(n[2] * inv, n[3] * inv); *(u32x2*)(H + (size_t)row * DM + h * 256 + 4 * lane) = o; } }
}

DI void act_fix_item(int item, const bf16_t* GS, const bf16_t* US, bf16_t* A2, const float* cw, const float* cb) {
    const int cch = item % (DFF / 8), rest = item / (DFF / 8), f = rest & 1, k = rest >> 1, c0 = cch * 8, row = 64 * k + f;
    const bool seq_start = (k & 31) == 0;
    float gm2[8], gm1[8], g[8], up[8], a[8];
    if (f == 0) {
        if (seq_start) {
#pragma unroll
            for (int j = 0; j < 8; ++j) { gm2[j] = 0.f; gm1[j] = 0.f; } }
        else { unpack8(*(const u32x4*)(GS + ((size_t)(k - 1) * 4 + 0) * DFF + c0), gm2); unpack8(*(const u32x4*)(GS + ((size_t)(k - 1) * 4 + 1) * DFF + c0), gm1); }
        unpack8(*(const u32x4*)(GS + ((size_t)k * 4 + 2) * DFF + c0), g);
    } else {
        if (seq_start) {
#pragma unroll
            for (int j = 0; j < 8; ++j) gm2[j] = 0.f; }
        else unpack8(*(const u32x4*)(GS + ((size_t)(k - 1) * 4 + 1) * DFF + c0), gm2);
        unpack8(*(const u32x4*)(GS + ((size_t)k * 4 + 2) * DFF + c0), gm1); unpack8(*(const u32x4*)(GS + ((size_t)k * 4 + 3) * DFF + c0), g);
    }
    unpack8(*(const u32x4*)(US + ((size_t)k * 2 + f) * DFF + c0), up);
#pragma unroll
    for (int j = 0; j < 8; ++j) a[j] = silu_f(cb[c0 + j] + cw[c0 + j] * gm2[j] + cw[DFF + c0 + j] * gm1[j] + cw[2 * DFF + c0 + j] * g[j]) * up[j];
    *(u32x4*)(A2 + (size_t)row * DFF + c0) = pack8(a);
}
DI void act_sample_item(int item, const bf16_t* SG, bf16_t* A2s, const float* cw, const float* cb, const float* hist  ) {
    const int cch = item % (DFF / 8), sb = item / (DFF / 8), c0 = cch * 8;
    float w0[8], w1[8], w2[8], bb[8], g2[8], g1[8], g0[8], up[8];
#pragma unroll
    for (int j = 0; j < 8; ++j) { w0[j] = cw[c0 + j]; w1[j] = cw[DFF + c0 + j]; w2[j] = cw[2 * DFF + c0 + j]; bb[j] = cb[c0 + j]; }
    { const float* hp = hist + (size_t)sb * 2 * DFF + c0;
#pragma unroll
      for (int j = 0; j < 8; ++j) { g0[j] = hp[j]; g1[j] = hp[DFF + j]; } }
    for (int r = 0; r < DSEQ; ++r) {
        const bf16_t* gp = SG + (size_t)(sb * DSEQ + r) * UPC + c0;
        unpack8(*(const u32x4*)gp, g2); unpack8(*(const u32x4*)(gp + DFF), up);
        float a[8];
#pragma unroll
        for (int j = 0; j < 8; ++j) { const float c = bb[j] + w0[j] * g0[j] + w1[j] * g1[j] + w2[j] * g2[j]; a[j] = silu_f(c) * up[j]; g0[j] = g1[j]; g1[j] = g2[j]; }
        *(u32x4*)(A2s + (size_t)(sb * DSEQ + r) * DFF + c0) = pack8(a);
    }
}
#define XB_TMO      128
#define XB_XCNT(j)  (256  + 64 * (j))
#define XB_XSUB(j)  (1280 + 64 * (j))
#define XB_XGEN(j)  (2304 + 64 * (j))
#define XB_TOP      3328
#define XB_TOPGEN   3392
#define XCD_BAR_WORDS 3456
#define XB_SPIN_CAP (1u << 18)

DI unsigned xb_ld(unsigned* p)              { return __hip_atomic_load(p, __ATOMIC_RELAXED, __HIP_MEMORY_SCOPE_AGENT); }
DI unsigned xb_add(unsigned* p, unsigned v) { return __hip_atomic_fetch_add(p, v, __ATOMIC_RELAXED, __HIP_MEMORY_SCOPE_AGENT); }
DI unsigned xb_xcc_id() { return (unsigned)__builtin_amdgcn_s_getreg((3 << 11) | 20) & 0xFu; }
#define XB_SPIN(cond, bar) do { unsigned _sp = 0; while (cond) { __builtin_amdgcn_s_sleep(1); \
    if ((++_sp & 255u) == 0u) { if (xb_ld(&(bar)[XB_TMO])) break; if (_sp > XB_SPIN_CAP) { atomicAdd(&(bar)[XB_TMO], 1u); break; } } } } while (0)

struct XcdBarrier {
    unsigned* bar; unsigned x;
    volatile LAS unsigned* st;
};

DI XcdBarrier xcd_barrier_post(unsigned* bar, volatile LAS unsigned* st) {
    XcdBarrier b; b.bar = bar; b.x = xb_xcc_id(); b.st = st;
    if (threadIdx.x == 0) (void)xb_add(&bar[XB_XCNT(b.x)], 1u);
    return b;
}
DI void xcd_barrier_complete(unsigned* bar, unsigned x, unsigned& nloc, unsigned& nx) {
    const unsigned G = gridDim.x * gridDim.y * gridDim.z;
    unsigned sum, cnt, mine, sp = 0u;
    for (;;) {
        sum = 0u; cnt = 0u; mine = 0u;
#pragma unroll
        for (unsigned j = 0; j < 16; ++j) { const unsigned c = xb_ld(&bar[XB_XCNT(j)]); sum += c; cnt += (c > 0u) ? 1u : 0u; mine = (j == x) ? c : mine; }
        if (sum == G) break;
        __builtin_amdgcn_s_sleep(1);
        if ((++sp & 255u) == 0u) { if (xb_ld(&bar[XB_TMO])) break; if (sp > XB_SPIN_CAP) { atomicAdd(&bar[XB_TMO], 1u); break; } }
    }
    nloc = mine > 0u ? mine : 1u; nx = cnt > 0u ? cnt : 1u;
}

DI void xcd_barrier(const XcdBarrier& b) {
    asm volatile("s_waitcnt vmcnt(0)" ::: "memory");
    __syncthreads();
    if (threadIdx.x == 0) {
        unsigned* bar = b.bar;
        __builtin_amdgcn_s_waitcnt(0);
        unsigned nloc = b.st[0], nx = b.st[1];
        if (nloc == 0u) { xcd_barrier_complete(bar, b.x, nloc, nx); b.st[0] = nloc; b.st[1] = nx; }
        const unsigned old = xb_add(&bar[XB_XSUB(b.x)], 1u);
        const unsigned gen = old / nloc;
        if (old + 1u == (gen + 1u) * nloc) {
            __builtin_amdgcn_fence(__ATOMIC_RELEASE, "agent");
            asm volatile("s_waitcnt vmcnt(0)" ::: "memory");
            const unsigned og = xb_add(&bar[XB_TOP], 1u);
            const unsigned tg = og / nx;
            if (og + 1u == (tg + 1u) * nx) xb_add(&bar[XB_TOPGEN], 1u);
            else XB_SPIN(xb_ld(&bar[XB_TOPGEN]) == tg, bar);
            __builtin_amdgcn_fence(__ATOMIC_ACQUIRE, "agent");
            xb_add(&bar[XB_XGEN(b.x)], 1u);
            asm volatile("s_waitcnt vmcnt(0)" ::: "memory");
        } else {
            XB_SPIN(xb_ld(&bar[XB_XGEN(b.x)]) == gen, bar);
            __builtin_amdgcn_fence(__ATOMIC_ACQUIRE, "agent");
            asm volatile("s_waitcnt vmcnt(0)" ::: "memory");
        }
    }
    __syncthreads();
}

__global__ void __launch_bounds__(NTHR, 2) fwd_megakernel(Params p_unused) {
    extern __shared__ __attribute__((aligned(16))) unsigned char lds_raw[];
    LAS unsigned char* lds = (LAS unsigned char*)lds_raw;
    cg::grid_group grid = cg::this_grid();
    const int G = gridDim.x, bx = blockIdx.x, ngw = G * NWAVES;
#define LAUNDER_T int tid = threadIdx.x; asm volatile("" : "+v"(tid)); const int lane = tid & 63, wid = __builtin_amdgcn_readfirstlane(tid >> 6), gw = bx * NWAVES + wid; (void)lane; (void)gw;
    { LAUNDER_T
      if (bx == 0) { unsigned* bw = (unsigned*)(kparams()->ws + WS_BAR); for (int i = tid; i < XCD_BAR_WORDS; i += NTHR) bw[i] = 0u; }
      if (tid < 2) ((LAS unsigned*)(lds + 131072 + 256))[tid] = 0u;
      phase_prologue(lds, gw, ngw, wid, lane); }
    grid.sync();
    XcdBarrier xbar = xcd_barrier_post((unsigned*)(kparams()->ws + WS_BAR), (volatile LAS unsigned*)(lds + 131072 + 256));
#define GRID_SYNC() xcd_barrier(xbar)

#define LAUNDER_L LAUNDER_T int l = l_; asm volatile("" : "+s"(l)); const KParams p = kparams(); unsigned char* ws = p->ws; float* outp = p->out; (void)outp;
#define WL ((const bf16_t*)(ws + WS_W) + (size_t)l * WL_STRIDE)
#define SSQ(n) ((acc_t*)(ws + WS_SSQ) + (size_t)(l * 3 + (n)) * R)
    for (int l_ = 0; l_ < DEPTH; ++l_) {
        { LAUNDER_L
          { pg8::SchedStd S; S.init((const bf16_t*)(ws + WS_XB), DM, WL + WL_IN, DM, R, INC, G, bx);
            pg8::EpiIn E{(bf16_t*)(ws + WS_Z), SSQ(0), outp + O_DVP + (size_t)l * RP * 512, outp + O_DVS + (size_t)l * RS * 512, (bf16_t*)(ws + WS_VT)}; pg8::gemm_phase(lds, tid, DM, DM, DM, S, E); }
          if (l == 0) { pg8::SchedStd S; S.init((const bf16_t*)(ws + WS_MB), DM, WL + WL_K, DM, MEMR, 2 * DM, G, bx);
            pg8::EpiKV E{(bf16_t*)(ws + WS_MK), (const float*)(ws + WS_SSQM), outp + O_MVP + (size_t)l * MEMR * DM, (bf16_t*)(ws + WS_MVT)}; pg8::gemm_phase(lds, tid, DM, DM, DM, S, E); } }
        GRID_SYNC();

        { LAUNDER_L
            bf16_t* Z = (bf16_t*)(ws + WS_Z); bf16_t* H = (bf16_t*)(ws + WS_H); bf16_t* MK = (bf16_t*)(ws + WS_MK);
            float* dkp = outp + O_DKP + (size_t)l * RP * 512; float* dks = outp + O_DKS + (size_t)l * RS * 512;
            float* mkp = outp + O_MKP + (size_t)l * MEMR * DM;
            const float* qg = p->in[10] + l * 64; const float* kg = p->in[11] + l * 64;
            qk_post_rows(Z, gw, ngw, qg, kg, dkp, dks, lane);
            for (int row = gw; row < MEMR; row += ngw) memk_post_row(MK, row, p->in[28] + l * 256, p->in[27] + l * 256, mkp, lane);
            acc_t* ssqq = (acc_t*)(ws + WS_SSQQ); acc_t* lsum = (acc_t*)(ws + WS_LSUM);
            for (int i = gw * 64 + lane; i < R * 4; i += ngw * 64) ssqq[i] = 0ull;
            for (int i = gw * 64 + lane; i < RP * 4; i += ngw * 64) lsum[i] = 0ull;
            __syncthreads();
            const float* Wsl = p->in[18] + (size_t)l * 4 * 128 * 128; const float* gmb = p->in[19] + l * 512; const float* gmg = p->in[17] + l * 128;
            int cached_g = -1;
            for (int un = bx; un < NBATCH * 16 * 4; un += G) gate_unit(un, cached_g, Z, H, Wsl, gmb, gmg, lds, tid, wid, lane);
            for (int un = bx; un < DB * 4; un += G) gate_sample_unit(un, Z, H, Wsl, gmb, gmg, outp + O_GVS + (size_t)l * RS * 512, lds, tid, wid, lane);
        }
        GRID_SYNC();

        { LAUNDER_L
            const bf16_t* Z = (const bf16_t*)(ws + WS_Z); bf16_t* H = (bf16_t*)(ws + WS_H); const bf16_t* VT = (const bf16_t*)(ws + WS_VT);
            const float lam_init = lam_init_of(l);
            float lam;
            { const float a = wave_sum(p->in[12][l * 64 + lane] * p->in[13][l * 64 + lane]), b = wave_sum(p->in[14][l * 64 + lane] * p->in[15][l * 64 + lane]);
              lam = __builtin_bit_cast(float, __builtin_amdgcn_readfirstlane(__builtin_bit_cast(int, expf(a) - expf(b) + lam_init))); }
            const float* subg = p->in[16] + l * 128; const float oscale = 1.0f - lam_init;
            for (int pr = bx; pr < NBATCH * 4 * 8; pr += G) { const int bh = pr >> 3, s = pr & 7;
                diff_attn_unit(bh >> 2, bh & 3, s, Z, VT, H, lam, subg, oscale, lds, wid, lane);
                diff_attn_unit(bh >> 2, bh & 3, 15 - s, Z, VT, H, lam, subg, oscale, lds, wid, lane); }
            for (int base = bx * 4; base < RS * 4; base += G * 4) { diff_attn_sample_pair(base + (wid >> 1), wid & 1, l, p->in[2], p->in[3], outp, Z, H, lam, subg, oscale, lds, wid, lane); __syncthreads(); }
        }
        GRID_SYNC();

        { LAUNDER_L pg8::SchedStd S; S.init((const bf16_t*)(ws + WS_H), DM, WL + WL_OUT, DM, R, DM, G, bx); pg8::EpiRes E{nullptr, (bf16_t*)(ws + WS_XB), SSQ(1)}; pg8::gemm_phase(lds, tid, DM, DM, DM, S, E); }
        if (l_ + 1 < DEPTH && bx >= 4) { LAUNDER_T int ln = l_ + 1; asm volatile("" : "+s"(ln));
            convert_layer_weights(ln, 0, (LAS float*)(lds + wid * 16384), (bx - 4) * NWAVES + wid, (G - 4) * NWAVES, lane); }
        GRID_SYNC();

        { LAUNDER_L pg8::SchedStd S; S.init((const bf16_t*)(ws + WS_XB), DM, WL + WL_Q, DM, R, DM, G, bx); pg8::EpiQ E{(bf16_t*)(ws + WS_Q), SSQ(1), (acc_t*)(ws + WS_SSQQ)}; pg8::gemm_phase(lds, tid, DM, DM, DM, S, E); }
        if (l_ + 1 < DEPTH && bx >= 4) { LAUNDER_T int ln = l_ + 1; asm volatile("" : "+s"(ln));
            convert_layer_weights(ln, 1, (LAS float*)(lds + wid * 16384), (bx - 4) * NWAVES + wid, (G - 4) * NWAVES, lane); }
        GRID_SYNC();

        { LAUNDER_L
          { pg8::SchedX S{G, bx, (const char*)(ws + WS_Q), (const char*)(ws + WS_MK), (size_t)256 * DM * 2, (size_t)256 * 2}; pg8::EpiS E{(bf16_t*)(ws + WS_P), (const acc_t*)(ws + WS_SSQQ), (acc_t*)(ws + WS_LSUM)}; pg8::gemm_phase(lds, tid, 256, DM, DM, S, E); }
          for (int base = bx * 4; base < RS * 4; base += G * 4) { cross_attn_sample_pair(base + (wid >> 1), wid & 1, l, p->in[4], p->in[5], (const bf16_t*)(ws + WS_Q), (const acc_t*)(ws + WS_SSQQ), p->in[27] + l * 256, (bf16_t*)(ws + WS_H), lds, wid, lane); __syncthreads(); } }

        { LAUNDER_L pg8::SchedX S{G, bx, (const char*)(ws + WS_P), (const char*)(ws + WS_MVT), (size_t)DM * 256 * 2, (size_t)256 * 256 * 2}; pg8::EpiPV E{(bf16_t*)(ws + WS_H), (const acc_t*)(ws + WS_LSUM)}; pg8::gemm_phase(lds, tid, 256, DM, 256, S, E); }
        GRID_SYNC();

        { LAUNDER_L pg8::SchedStd S; S.init((const bf16_t*)(ws + WS_H), DM, WL + WL_O, DM, R, DM, G, bx); pg8::EpiRes E{nullptr, (bf16_t*)(ws + WS_XB), SSQ(2)}; pg8::gemm_phase(lds, tid, DM, DM, DM, S, E); }
        if (l_ + 1 < DEPTH && bx >= 4) { LAUNDER_T int ln = l_ + 1; asm volatile("" : "+s"(ln));
            convert_layer_weights(ln, 2, (LAS float*)(lds + wid * 16384), (bx - 4) * NWAVES + wid, (G - 4) * NWAVES, lane); }
        GRID_SYNC();

        { LAUNDER_L pg8::SchedStd S; S.init((const bf16_t*)(ws + WS_XB), DM, WL + WL_UP, DM, R, UPC, G, bx);
          pg8::EpiUpAct E{(bf16_t*)(ws + WS_A2), SSQ(2), (bf16_t*)(ws + WS_GS), (bf16_t*)(ws + WS_US), (bf16_t*)(ws + WS_SG), p->in[31] + (size_t)l * 3 * DFF, p->in[32] + (size_t)l * DFF,
                              outp + O_FCP + (size_t)l * NBATCH * 2 * DFF, outp + O_FCS + (size_t)l * DB * 2 * DFF}; pg8::gemm_phase(lds, tid, DM, DM, DM, S, E); }
        GRID_SYNC();

        { LAUNDER_L
            const float* cw = p->in[31] + (size_t)l * 3 * DFF; const float* cb = p->in[32] + (size_t)l * DFF; const float* hist = p->in[6] + (size_t)l * DB * 2 * DFF;
            for (int item = bx * NTHR + tid; item < (RP / 64) * 2 * (DFF / 8); item += G * NTHR) act_fix_item(item, (const bf16_t*)(ws + WS_GS), (const bf16_t*)(ws + WS_US), (bf16_t*)(ws + WS_A2), cw, cb);
            for (int item = bx * NTHR + tid; item < DB * (DFF / 8); item += G * NTHR) act_sample_item(item, (const bf16_t*)(ws + WS_SG), (bf16_t*)(ws + WS_A2) + (size_t)RP * DFF, cw, cb, hist);
        }
        GRID_SYNC();

        { LAUNDER_L pg8::SchedStd S; S.init((const bf16_t*)(ws + WS_A2), DFF, WL + WL_DN, DFF, R, DM, G, bx);
          pg8::EpiRes E{(l + 1 < DEPTH) ? nullptr : outp + O_Y, (bf16_t*)(ws + WS_XB), (l + 1 < DEPTH) ? (acc_t*)(ws + WS_SSQ) + (size_t)((l + 1) * 3) * R : nullptr}; pg8::gemm_phase(lds, tid, DFF, DFF, DFF, S, E); }
        { LAUNDER_L
          if (l + 1 < DEPTH) { const bf16_t* wn = (const bf16_t*)(ws + WS_W) + (size_t)(l + 1) * WL_STRIDE;
            pg8::SchedStd S2; S2.init((const bf16_t*)(ws + WS_MB), DM, wn + WL_K, DM, MEMR, 2 * DM, G - 4, bx - 4);
            pg8::EpiKV E2{(bf16_t*)(ws + WS_MK), (const float*)(ws + WS_SSQM), outp + O_MVP + (size_t)(l + 1) * MEMR * DM, (bf16_t*)(ws + WS_MVT)}; pg8::gemm_phase(lds, tid, DM, DM, DM, S2, E2); } }
        GRID_SYNC();
    }
}

extern "C" void kernel_launch(void* const* d_in, const int* in_sizes, int n_in, void* d_out, int out_size, void* d_ws, size_t ws_size, hipStream_t stream) {
    static int grid = 0;
    if (grid == 0) {
        if (n_in != 34 || (size_t)out_size != O_END || ws_size < WS_END) {
            fprintf(stderr, "kernel_launch: unexpected problem: n_in %d out_size %d (want %zu) ws %zu (need %zu); nothing launched\n", n_in, out_size, (size_t)O_END, ws_size, (size_t)WS_END); grid = -1; return; }
        int dev = 0, cus = 0, per_cu = 0;
        (void)hipGetDevice(&dev); (void)hipDeviceGetAttribute(&cus, hipDeviceAttributeMultiprocessorCount, dev);
        if (hipFuncSetAttribute((const void*)fwd_megakernel, hipFuncAttributeMaxDynamicSharedMemorySize, LDS_BYTES) != hipSuccess) { fprintf(stderr, "kernel_launch: hipFuncSetAttribute failed\n"); }
        if (hipOccupancyMaxActiveBlocksPerMultiprocessor(&per_cu, (const void*)fwd_megakernel, NTHR, LDS_BYTES) != hipSuccess || per_cu < 1) { fprintf(stderr, "kernel_launch: occupancy query says %d\n", per_cu); per_cu = 1; }
        (void)hipGetLastError();
        grid = cus * 1;
        if (grid <= 0) grid = 256;
    }
    if (grid < 0) return;
    Params p{};
    for (int i = 0; i < 34; ++i) p.in[i] = (const float*)d_in[i];
    p.out = (float*)d_out; p.ws = (unsigned char*)d_ws;
    void* args[] = {&p};
    hipError_t e = hipLaunchCooperativeKernel((const void*)fwd_megakernel, dim3(grid), dim3(NTHR), args, LDS_BYTES, stream);
    if (e != hipSuccess) fprintf(stderr, "kernel_launch: cooperative launch failed: %s (grid %d)\n", hipGetErrorString(e), grid);
}
```

```cpp
#include <hip/hip_runtime.h>
#include <hip/hip_cooperative_groups.h>
#include <cstdio>
#include <cstdint>
namespace cg = cooperative_groups;

#define LAS __attribute__((address_space(3)))
#define DI __device__ __forceinline__
typedef unsigned short bf16_t;
typedef short bf16x8 __attribute__((ext_vector_type(8)));
typedef float f32x4 __attribute__((ext_vector_type(4)));
typedef float f32x2 __attribute__((ext_vector_type(2)));
typedef float f32x16 __attribute__((ext_vector_type(16)));
typedef unsigned u32x4 __attribute__((ext_vector_type(4)));
typedef unsigned u32x2 __attribute__((ext_vector_type(2)));
typedef __bf16 bf16x2_t __attribute__((ext_vector_type(2)));

constexpr int DM = 1024, SEQ = 2048, NBATCH = 32, DEPTH = 4, RP = NBATCH * SEQ, DB = 8, DSEQ = 32, RS = DB * DSEQ, R = RP + RS;
constexpr int PAST = 1024, INC = 2560, DFF = 2816, UPC = 2 * DFF, MEMR = NBATCH * 256, NWAVES = 8, NTHR = 512;
constexpr float EPS = 1e-6f, LOG2E = 1.4426950408889634f;
constexpr float QSCALE = 0.125f * LOG2E;
constexpr float XSCALE = 0.0625f * LOG2E;

constexpr size_t O_Y = 0;
constexpr size_t O_DKP = (size_t)R * DM;
constexpr size_t O_DVP = O_DKP + (size_t)DEPTH * RP * 512;
constexpr size_t O_MKP = O_DVP + (size_t)DEPTH * RP * 512;
constexpr size_t O_MVP = O_MKP + (size_t)DEPTH * MEMR * DM;
constexpr size_t O_FCP = O_MVP + (size_t)DEPTH * MEMR * DM;
constexpr size_t O_DKS = O_FCP + (size_t)DEPTH * NBATCH * 2 * DFF;
constexpr size_t O_DVS = O_DKS + (size_t)DEPTH * RS * 512;
constexpr size_t O_GVS = O_DVS + (size_t)DEPTH * RS * 512;
constexpr size_t O_FCS = O_GVS + (size_t)DEPTH * RS * 512;
constexpr size_t O_END = O_FCS + (size_t)DEPTH * DB * 2 * DFF;

constexpr size_t MiB = 1u << 20;
constexpr size_t WS_SSQ = 0;
constexpr size_t WS_SSQM = 6 * MiB + MiB / 2;
constexpr size_t WS_BAR = 6 * MiB + MiB / 2 + 65536;
constexpr size_t WS_SSQQ = 6 * MiB + 3 * MiB / 4;
constexpr size_t WS_LSUM = 9 * MiB;
constexpr size_t WS_W = 11 * MiB;
constexpr size_t WS_XB = 137 * MiB;
constexpr size_t WS_MB = 266 * MiB;
constexpr size_t WS_MK = 282 * MiB;
constexpr size_t WS_MVT = 298 * MiB;
constexpr size_t WS_A = 314 * MiB;
constexpr size_t WS_Z = WS_A;
constexpr size_t WS_P = WS_A;
constexpr size_t WS_H = WS_A + 322 * MiB;
constexpr size_t WS_Q = WS_A + 451 * MiB;
constexpr size_t WS_VT = WS_Q;
constexpr size_t WS_A2 = WS_A;
constexpr size_t WS_GS = WS_A + 451 * MiB;
constexpr size_t WS_US = WS_A + 474 * MiB;
constexpr size_t WS_SG = WS_A + 486 * MiB;
constexpr size_t WS_END = WS_A + 580 * MiB;
static_assert((size_t)R * INC * 2 <= 322 * MiB && (size_t)R * DM * 2 <= 129 * MiB && (size_t)R * DFF * 2 <= 451 * MiB && (size_t)(RP / 64) * 4 * DFF * 2 <= 23 * MiB && (size_t)(RP / 64) * 2 * DFF * 2 <= 12 * MiB && (size_t)RS * UPC * 2 <= 3 * MiB, "region A map");
static_assert((size_t)DEPTH * 3 * R * 8 <= WS_SSQM && WS_SSQM + MEMR * 4 <= WS_SSQQ && WS_SSQQ + (size_t)R * 32 <= WS_LSUM && WS_LSUM + (size_t)RP * 32 <= WS_W, "ctl map");
constexpr size_t WL_IN = 0, WL_OUT = WL_IN + (size_t)INC * DM, WL_Q = WL_OUT + (size_t)DM * DM, WL_K = WL_Q + (size_t)DM * DM, WL_V = WL_K + (size_t)DM * DM,
                 WL_O = WL_V + (size_t)DM * DM, WL_UP = WL_O + (size_t)DM * DM, WL_DN = WL_UP + (size_t)UPC * DM, WL_STRIDE = WL_DN + (size_t)DM * DFF;
static_assert(WS_W + DEPTH * WL_STRIDE * 2 <= WS_XB, "weights map");

constexpr int LDS_BYTES = 147456;

struct Params {
    const float* in[34];
    float* out;
    unsigned char* ws;
};
typedef const Params __attribute__((address_space(4)))* KParams;
DI KParams kparams() { KParams kp = (KParams)__builtin_amdgcn_kernarg_segment_ptr(); asm volatile("" : "+s"(kp)); return kp; }

DI unsigned pk2(float lo, float hi) { f32x2 v = {lo, hi}; bf16x2_t b = __builtin_convertvector(v, bf16x2_t); return __builtin_bit_cast(unsigned, b); }
DI float bflo(unsigned w) { return __uint_as_float(w << 16); }
DI float bfhi(unsigned w) { return __uint_as_float(w & 0xffff0000u); }
DI float wave_sum(float v) {
#pragma unroll
    for (int o = 1; o < 64; o <<= 1) v += __shfl_xor(v, o);
    return v;
}
DI float wave_max(float v) {
#pragma unroll
    for (int o = 1; o < 64; o <<= 1) v = fmaxf(v, __shfl_xor(v, o));
    return v;
}
DI float gelu_t(float x) {
    const float u = 0.7978845608028654f * (x + 0.044715f * x * x * x);
    const float e = __builtin_amdgcn_exp2f(-2.f * LOG2E * u);
    return x * __builtin_amdgcn_rcpf(1.f + e);
}
DI float silu_f(float x) { return x * __builtin_amdgcn_rcpf(1.f + __builtin_amdgcn_exp2f(-LOG2E * x)); }
DI float rstd_of(float ssq, float inv_n) { return 1.0f / sqrtf(ssq * inv_n + EPS); }
typedef unsigned long long acc_t;
constexpr float SSQ_SCALE = 1048576.0f, LS_SCALE = 16777216.0f;
DI void acc_add(acc_t* p, float v, float scale) { atomicAdd(p, (acc_t)(v * scale)); }
DI float acc_get(const acc_t* p, float inv_scale) { return (float)(*p) * inv_scale; }
DI float acc_get_i(const acc_t* base, unsigned idx, float inv_scale) { return (float)(*(const acc_t*)((const char*)base + idx * 8u)) * inv_scale; }
DI void unpack8(const u32x4 w, float (&v)[8]) {
    v[0] = bflo(w.x); v[1] = bfhi(w.x); v[2] = bflo(w.y); v[3] = bfhi(w.y); v[4] = bflo(w.z); v[5] = bfhi(w.z); v[6] = bflo(w.w); v[7] = bfhi(w.w);
}
DI u32x4 pack8(const float (&v)[8]) { u32x4 w; w.x = pk2(v[0], v[1]); w.y = pk2(v[2], v[3]); w.z = pk2(v[4], v[5]); w.w = pk2(v[6], v[7]); return w; }
template <class T> DI T* boff(T* base, unsigned byte_off) { return (T*)((char*)base + byte_off); }
DI float lam_init_of(int l) { return l == 0 ? 0.2f : l == 1 ? 0.35550906759096934f : l == 2 ? 0.4707130183435842f : 0.5560582041556406f; }
namespace pg8 {
constexpr int BM = 256, BK = 64, HALF = 128, HTB = HALF * BK * 2, STAGE_BYTES = 8 * HTB, NXCD = 8, WGM = 8;
DI int lds_byte(int r, int c) { const int st = (r >> 4) * 2 + (c >> 5), rr = r & 15, cc = c & 31, ob = rr * 64 + cc * 2; return st * 1024 + (ob ^ (((ob >> 9) & 1) << 5)); }
DI void stage_rc(int b, int& Rr, int& C) { const int st = b / 1024, sb = b % 1024, swz = sb ^ (((sb >> 9) & 1) << 5); Rr = (st >> 1) * 16 + swz / 64; C = (st & 1) * 32 + (swz % 64) / 2; }
DI int perm32(int rho) { const int n = rho >> 4, i = rho & 15; return 8 * (i >> 2) + 4 * n + (i & 3); }
struct Unit { int pm, pn; };

struct SchedStd {
    int nM, nN, nwg, G, c; const char* A; const char* B; size_t tA, tB;
    DI void init(const bf16_t* A_, int lda, const bf16_t* B_, int ldb, int M, int N, int G_, int c_) { nM = M / BM; nN = N / BM; nwg = nM * nN; G = G_; c = c_; A = (const char*)A_; B = (const char*)B_; tA = (size_t)BM * lda * 2; tB = (size_t)BM * ldb * 2; }
    DI bool next(int i, Unit& u) const {
        const long L = (long)i * G + c; if (c < 0 || L >= nwg) return false;
        int wgid = (int)L; { const int q = nwg / NXCD, r = nwg % NXCD, xcd = wgid % NXCD, off = wgid / NXCD; wgid = (xcd < r ? xcd * (q + 1) : r * (q + 1) + (xcd - r) * q) + off; }
        const int nig = WGM * nN, gid = wgid / nig, fm = gid * WGM, gsz = (nM - fm) < WGM ? (nM - fm) : WGM;
        u.pm = fm + ((wgid % nig) % gsz); u.pn = (wgid % nig) / gsz; return true;
    }
    DI const char* a_base(const Unit& u) const { return A + (size_t)u.pm * tA; }
    DI const char* b_base(const Unit& u) const { return B + (size_t)u.pn * tB; }
};
struct SchedX {
    int G, c; const char* A; const char* B; size_t bB, hB;
    DI bool next(int i, Unit& u) const { const int L = i * G + c; if (L >= (RP / BM) * 4) return false; u.pm = L >> 2; u.pn = L & 3; return true; }
    DI const char* a_base(const Unit& u) const { return A + ((size_t)u.pm * BM * DM + (size_t)u.pn * 256) * 2; }
    DI const char* b_base(const Unit& u) const { return B + (size_t)(u.pm >> 3) * bB + (size_t)u.pn * hB; }
};

template <class Epi, class Sched>
DI void gemm_phase(LAS unsigned char* lds, const int tid, const int K, const int lda, const int ldb, const Sched& S, const Epi& E) {
    const int wid = __builtin_amdgcn_readfirstlane(tid >> 6), lane = tid & 63, wr = wid >> 2, wc = wid & 3, fr = lane & 15, fq = lane >> 4;
    const int nt = K / BK;
    unsigned voffA[2], voffB[2];
#pragma unroll
    for (int i = 0; i < 2; ++i) { int Rr, C; stage_rc(tid * 16 + i * 8192, Rr, C); const int Rb = Epi::PERM ? ((Rr & ~31) + perm32(Rr & 31)) : Rr;
        voffA[i] = (unsigned)(Rr * lda + C) * 2u; voffB[i] = (unsigned)(Rb * ldb + C) * 2u; }
    const size_t kstep = (size_t)(BK * 2);
    const size_t hA = (size_t)HALF * lda * 2, hB = (size_t)HALF * ldb * 2;
    const unsigned ldsw = (unsigned)wid * 1024u;
    const int aoff = lds_byte(wr * 64 + fr, fq * 8), boff = lds_byte(wc * 32 + fr, fq * 8);
#define PG8_SA(b, h) (((b) * 2 + (h)) * HTB)
#define PG8_SB(b, h) ((4 + (b) * 2 + (h)) * HTB)
#define PG8_STAGE(bufoff, gbase, voff) do { _Pragma("unroll") for (int _i = 0; _i < 2; ++_i) \
        __builtin_amdgcn_global_load_lds((const unsigned*)((const char*)(gbase) + (voff)[_i]), (LAS unsigned*)(lds + (bufoff) + ldsw + _i * 8192), 16, 0, 0); } while (0)
#define PG8_LDA(dst, b, h) do { _Pragma("unroll") for (int m = 0; m < 4; ++m) _Pragma("unroll") for (int k = 0; k < 2; ++k) dst[m][k] = *(const LAS bf16x8*)(lds + PG8_SA(b, h) + aoff + m * 2048 + k * 1024); } while (0)
#define PG8_LDB(dst, b, h) do { _Pragma("unroll") for (int n = 0; n < 2; ++n) _Pragma("unroll") for (int k = 0; k < 2; ++k) dst[n][k] = *(const LAS bf16x8*)(lds + PG8_SB(b, h) + boff + n * 2048 + k * 1024); } while (0)
#define PG8_MMA(ai, bj, At, Bt) do { __builtin_amdgcn_s_setprio(1); _Pragma("unroll") for (int m = 0; m < 4; ++m) _Pragma("unroll") for (int n = 0; n < 2; ++n) _Pragma("unroll") for (int k = 0; k < 2; ++k) \
        acc[ai][bj][m][n] = __builtin_amdgcn_mfma_f32_16x16x32_bf16(Bt[n][k], At[m][k], acc[ai][bj][m][n], 0, 0, 0); __builtin_amdgcn_s_setprio(0); } while (0)
#define PG8_WAIT_V(n) asm volatile("s_waitcnt vmcnt(" #n ")" ::: "memory")
#define PG8_WAIT_L(n) asm volatile("s_waitcnt lgkmcnt(" #n ")" ::: "memory")
#define PG8_BAR __builtin_amdgcn_s_barrier()
#define PG8_SCHED __builtin_amdgcn_sched_barrier(0)
    Unit cur, nxt; int ui = 0;
    if (!S.next(0, cur)) return;
    f32x4 acc[2][2][4][2];
#pragma unroll
    for (int a = 0; a < 2; ++a)
#pragma unroll
        for (int b = 0; b < 2; ++b)
#pragma unroll
            for (int m = 0; m < 4; ++m)
#pragma unroll
                for (int n = 0; n < 2; ++n) acc[a][b][m][n] = (f32x4){0.f, 0.f, 0.f, 0.f};
    bf16x8 At[4][2], B0[2][2], B1[2][2];
    const char* cA = S.a_base(cur); const char* cB = S.b_base(cur);
    PG8_STAGE(PG8_SB(0, 0), cB, voffB); PG8_STAGE(PG8_SB(0, 1), cB + hB, voffB); PG8_STAGE(PG8_SA(0, 0), cA, voffA); PG8_STAGE(PG8_SA(0, 1), cA + hA, voffA);
    if (wr == 1) PG8_BAR;
    PG8_WAIT_V(2); PG8_BAR;
    PG8_STAGE(PG8_SB(1, 0), cB + kstep, voffB); PG8_STAGE(PG8_SA(1, 0), cA + kstep, voffA); PG8_STAGE(PG8_SB(1, 1), cB + hB + kstep, voffB);
    PG8_WAIT_V(6); PG8_BAR;
    for (;;) {
        const bool has_next = S.next(ui + 1, nxt);
        const char* nA = has_next ? S.a_base(nxt) : cA; const char* nB = has_next ? S.b_base(nxt) : cB;
#pragma unroll 1
        for (int t = 0; t < nt; t += 2) {
            const bool last = (t == nt - 2);
            const char* a1 = cA + (size_t)(t + 1) * kstep;
            const char* a2 = last ? nA : cA + (size_t)(t + 2) * kstep; const char* b2 = last ? nB : cB + (size_t)(t + 2) * kstep;
            const char* a3 = a2 + kstep; const char* b3 = b2 + kstep;
            PG8_LDB(B0, 0, 0); PG8_LDB(B1, 0, 1); PG8_SCHED; PG8_LDA(At, 0, 0); PG8_STAGE(PG8_SA(1, 1), a1 + hA, voffA);
            PG8_WAIT_V(8); PG8_WAIT_L(0); PG8_BAR; PG8_MMA(0, 0, At, B0); PG8_MMA(0, 1, At, B1); PG8_BAR; PG8_SCHED;
            PG8_LDA(At, 0, 1); PG8_STAGE(PG8_SB(0, 0), b2, voffB); PG8_STAGE(PG8_SB(0, 1), b2 + hB, voffB); PG8_STAGE(PG8_SA(0, 0), a2, voffA);
            PG8_WAIT_V(8); PG8_WAIT_L(0); PG8_BAR; PG8_MMA(1, 0, At, B0); PG8_MMA(1, 1, At, B1); PG8_BAR; PG8_SCHED;
            PG8_LDB(B0, 1, 0); PG8_LDB(B1, 1, 1); PG8_SCHED; PG8_LDA(At, 1, 0); PG8_STAGE(PG8_SA(0, 1), a2 + hA, voffA);
            PG8_WAIT_V(8); PG8_WAIT_L(0); PG8_BAR; PG8_MMA(0, 0, At, B0); PG8_MMA(0, 1, At, B1); PG8_BAR; PG8_SCHED;
            PG8_LDA(At, 1, 1); PG8_STAGE(PG8_SB(1, 0), b3, voffB); PG8_STAGE(PG8_SB(1, 1), b3 + hB, voffB); PG8_STAGE(PG8_SA(1, 0), a3, voffA);
            PG8_WAIT_V(8); PG8_WAIT_L(0); PG8_BAR; PG8_MMA(1, 0, At, B0); PG8_MMA(1, 1, At, B1); PG8_BAR; PG8_SCHED;
        }
        if (wr == 0) PG8_BAR;
        E(acc, cur, wr, wc, fr, fq);
        if (!has_next) break;
#pragma unroll
        for (int a = 0; a < 2; ++a)
#pragma unroll
            for (int b = 0; b < 2; ++b)
#pragma unroll
                for (int m = 0; m < 4; ++m)
#pragma unroll
                    for (int n = 0; n < 2; ++n) acc[a][b][m][n] = (f32x4){0.f, 0.f, 0.f, 0.f};
        cur = nxt; cA = nA; cB = nB; ++ui;
        if (wr == 1) PG8_BAR;
    }
    PG8_WAIT_V(0);
    PG8_BAR;
#undef PG8_SA
#undef PG8_SB
#undef PG8_STAGE
#undef PG8_LDA
#undef PG8_LDB
#undef PG8_MMA
#undef PG8_WAIT_V
#undef PG8_WAIT_L
#undef PG8_BAR
#undef PG8_SCHED
}

#define EPI_ROWS_BEGIN _Pragma("unroll") for (int ai = 0; ai < 2; ++ai) _Pragma("unroll") for (int m = 0; m < 4; ++m) { const int row = u.pm * BM + ai * HALF + wr * 64 + m * 16 + fr;
#define EPI_ROWS_END }


DI void store_pair_transposed(bf16_t* Tcol0, int pitch, int r, int fr, unsigned w01, unsigned w23, unsigned w45, unsigned w67) {
    const bool odd = fr & 1;
    const unsigned s0 = odd ? w01 : w45, s1 = odd ? w23 : w67;
    const unsigned r0 = __shfl_xor(s0, 1), r1 = __shfl_xor(s1, 1);
    const unsigned X0 = odd ? r0 : w01, X1 = odd ? r1 : w23, Y0 = odd ? w45 : r0, Y1 = odd ? w67 : r1;
    bf16_t* base = Tcol0 + (size_t)(odd ? 4 : 0) * pitch + (r & ~1);
    *(unsigned*)(base) = (X0 & 0xffffu) | (Y0 << 16);
    *(unsigned*)(base + pitch) = (X0 >> 16) | (Y0 & 0xffff0000u);
    *(unsigned*)(base + 2 * (size_t)pitch) = (X1 & 0xffffu) | (Y1 << 16);
    *(unsigned*)(base + 3 * (size_t)pitch) = (X1 >> 16) | (Y1 & 0xffff0000u);
}
struct EpiIn {
    static constexpr bool PERM = true;
    bf16_t* Z; const acc_t* ssq; float* dvp; float* dvs; bf16_t* VT;
    DI void operator()(const f32x4 (&acc)[2][2][4][2], const Unit& u, int wr, int wc, int fr, int fq) const {
        const int colb = u.pn * BM + wc * 32 + 8 * fq;
        EPI_ROWS_BEGIN
            const float rs = rstd_of(acc_get(ssq + row, 1.0f / SSQ_SCALE), 1.0f / DM);
#pragma unroll
            for (int bj = 0; bj < 2; ++bj) { const int col = colb + bj * HALF; f32x4 v0 = acc[ai][bj][m][0] * rs, v1 = acc[ai][bj][m][1] * rs;
                if (u.pn == 4 || u.pn == 5) { float* dst = (row < RP ? dvp + (size_t)row * 512 : dvs + (size_t)(row - RP) * 512) + (col - 1024); *(f32x4*)dst = v0; *(f32x4*)(dst + 4) = v1;
                    if (u.pm < RP / BM) store_pair_transposed(VT + ((size_t)(row >> 11) * 512 + (col - 1024)) * SEQ, SEQ, row & (SEQ - 1), fr, pk2(v0[0], v0[1]), pk2(v0[2], v0[3]), pk2(v1[0], v1[1]), pk2(v1[2], v1[3])); }
                else { if (u.pn >= 6) {
#pragma unroll
                        for (int j = 0; j < 4; ++j) { v0[j] = gelu_t(v0[j]); v1[j] = gelu_t(v1[j]); } }
                    u32x4 w; w.x = pk2(v0[0], v0[1]); w.y = pk2(v0[2], v0[3]); w.z = pk2(v1[0], v1[1]); w.w = pk2(v1[2], v1[3]);
                    *(u32x4*)(Z + (size_t)row * INC + col) = w; } }
        EPI_ROWS_END
    }
};
struct EpiKV {
    static constexpr bool PERM = true;
    bf16_t* MK; const float* ssq; float* mvp; bf16_t* MVT;
    DI void operator()(const f32x4 (&acc)[2][2][4][2], const Unit& u, int wr, int wc, int fr, int fq) const {
        const int colb = (u.pn & 3) * BM + wc * 32 + 8 * fq;
        EPI_ROWS_BEGIN
            const float rs = rstd_of(ssq[row], 1.0f / DM);
#pragma unroll
            for (int bj = 0; bj < 2; ++bj) { const int col = colb + bj * HALF; const f32x4 v0 = acc[ai][bj][m][0] * rs, v1 = acc[ai][bj][m][1] * rs;
                if (u.pn >= 4) { float* dst = mvp + (size_t)row * DM + col; *(f32x4*)dst = v0; *(f32x4*)(dst + 4) = v1;
                    store_pair_transposed(MVT + ((size_t)(row >> 8) * DM + col) * 256, 256, row & 255, fr, pk2(v0[0], v0[1]), pk2(v0[2], v0[3]), pk2(v1[0], v1[1]), pk2(v1[2], v1[3])); }
                else { u32x4 w; w.x = pk2(v0[0], v0[1]); w.y = pk2(v0[2], v0[3]); w.z = pk2(v1[0], v1[1]); w.w = pk2(v1[2], v1[3]); *(u32x4*)(MK + (size_t)row * DM + col) = w; } }
        EPI_ROWS_END
    }
};
struct EpiRes {
    static constexpr bool PERM = true;
    float* Y; bf16_t* XB; acc_t* ssq_next;
    DI void operator()(const f32x4 (&acc)[2][2][4][2], const Unit& u, int wr, int wc, int fr, int fq) const {
        const int colb = u.pn * BM + wc * 32 + 8 * fq;
        EPI_ROWS_BEGIN
            float ss = 0.f;
#pragma unroll
            for (int bj = 0; bj < 2; ++bj) { const int col = colb + bj * HALF; bf16_t* xp = XB + (size_t)row * DM + col;
                float xv[8]; unpack8(*(const u32x4*)xp, xv);
                const f32x4 x0 = (f32x4){xv[0], xv[1], xv[2], xv[3]} + acc[ai][bj][m][0], x1 = (f32x4){xv[4], xv[5], xv[6], xv[7]} + acc[ai][bj][m][1];
                if (Y != nullptr) { float* yp = Y + (size_t)row * DM + col; *(f32x4*)yp = x0; *(f32x4*)(yp + 4) = x1; }
                u32x4 w; w.x = pk2(x0[0], x0[1]); w.y = pk2(x0[2], x0[3]); w.z = pk2(x1[0], x1[1]); w.w = pk2(x1[2], x1[3]); *(u32x4*)xp = w;
                ss += (x0[0] * x0[0] + x0[1] * x0[1]) + (x0[2] * x0[2] + x0[3] * x0[3]) + (x1[0] * x1[0] + x1[1] * x1[1]) + (x1[2] * x1[2] + x1[3] * x1[3]); }
            ss += __shfl_xor(ss, 16); ss += __shfl_xor(ss, 32);
            if (ssq_next != nullptr && fq == 0) acc_add(ssq_next + row, ss, SSQ_SCALE);
        EPI_ROWS_END
    }
};

struct EpiQ {
    static constexpr bool PERM = true;
    bf16_t* Q; const acc_t* ssq; acc_t* ssqq;
    DI void operator()(const f32x4 (&acc)[2][2][4][2], const Unit& u, int wr, int wc, int fr, int fq) const {
        const int colb = u.pn * BM + wc * 32 + 8 * fq;
        EPI_ROWS_BEGIN
            const float rs = rstd_of(acc_get(ssq + row, 1.0f / SSQ_SCALE), 1.0f / DM); float ss = 0.f;
#pragma unroll
            for (int bj = 0; bj < 2; ++bj) { const int col = colb + bj * HALF; const f32x4 v0 = acc[ai][bj][m][0] * rs, v1 = acc[ai][bj][m][1] * rs;
                u32x4 w; w.x = pk2(v0[0], v0[1]); w.y = pk2(v0[2], v0[3]); w.z = pk2(v1[0], v1[1]); w.w = pk2(v1[2], v1[3]); *(u32x4*)(Q + (size_t)row * DM + col) = w;
                ss += (v0[0] * v0[0] + v0[1] * v0[1]) + (v0[2] * v0[2] + v0[3] * v0[3]) + (v1[0] * v1[0] + v1[1] * v1[1]) + (v1[2] * v1[2] + v1[3] * v1[3]); }
            ss += __shfl_xor(ss, 16); ss += __shfl_xor(ss, 32);
            if (fq == 0) acc_add(ssqq + (size_t)row * 4 + u.pn, ss, SSQ_SCALE);
        EPI_ROWS_END
    }
};
struct EpiS {
    static constexpr bool PERM = true;
    bf16_t* P; const acc_t* ssqq; acc_t* lsum;
    DI void operator()(const f32x4 (&acc)[2][2][4][2], const Unit& u, int wr, int wc, int fr, int fq) const {
        const int colb = u.pn * BM + wc * 32 + 8 * fq;
        EPI_ROWS_BEGIN
            const float rs = rstd_of(acc_get(ssqq + (size_t)row * 4 + u.pn, 1.0f / SSQ_SCALE), 1.0f / 256.f) * XSCALE; float ss = 0.f;
#pragma unroll
            for (int bj = 0; bj < 2; ++bj) { const int col = colb + bj * HALF; f32x4 v0 = acc[ai][bj][m][0] * rs, v1 = acc[ai][bj][m][1] * rs;
#pragma unroll
                for (int j = 0; j < 4; ++j) { v0[j] = __builtin_amdgcn_exp2f(v0[j]); v1[j] = __builtin_amdgcn_exp2f(v1[j]); }
                u32x4 w; w.x = pk2(v0[0], v0[1]); w.y = pk2(v0[2], v0[3]); w.z = pk2(v1[0], v1[1]); w.w = pk2(v1[2], v1[3]); *(u32x4*)(P + (size_t)row * DM + col) = w;
                ss += (v0[0] + v0[1]) + (v0[2] + v0[3]) + (v1[0] + v1[1]) + (v1[2] + v1[3]); }
            ss += __shfl_xor(ss, 16); ss += __shfl_xor(ss, 32);
            if (fq == 0) acc_add(lsum + (size_t)row * 4 + u.pn, ss, LS_SCALE);
        EPI_ROWS_END
    }
};
struct EpiPV {
    static constexpr bool PERM = true;
    bf16_t* H; const acc_t* lsum;
    DI void operator()(const f32x4 (&acc)[2][2][4][2], const Unit& u, int wr, int wc, int fr, int fq) const {
        const int colb = u.pn * BM + wc * 32 + 8 * fq;
        EPI_ROWS_BEGIN
            const float rs = 1.0f / acc_get(lsum + (size_t)row * 4 + u.pn, 1.0f / LS_SCALE);
#pragma unroll
            for (int bj = 0; bj < 2; ++bj) { const int col = colb + bj * HALF; const f32x4 v0 = acc[ai][bj][m][0] * rs, v1 = acc[ai][bj][m][1] * rs;
                u32x4 w; w.x = pk2(v0[0], v0[1]); w.y = pk2(v0[2], v0[3]); w.z = pk2(v1[0], v1[1]); w.w = pk2(v1[2], v1[3]); *(u32x4*)(H + (size_t)row * DM + col) = w; }
        EPI_ROWS_END
    }
};
struct EpiUpAct {
    static constexpr bool PERM = true;
    bf16_t* A2; const acc_t* ssq; bf16_t* GS; bf16_t* US; bf16_t* SG; const float* cw; const float* cb; float* fcp; float* fcs;
    DI void operator()(const f32x4 (&acc)[2][2][4][2], const Unit& u, int wr, int wc, int fr, int fq) const {
        const int c8 = u.pn * HALF + wc * 32 + 8 * fq;
        if (u.pm == RP / BM) {
            Unit uu = u; asm volatile("" : "+s"(uu.pm));
            const Unit& u = uu;
            EPI_ROWS_BEGIN
                const float rs = rstd_of(acc_get(ssq + row, 1.0f / SSQ_SCALE), 1.0f / DM); const int sr = row - RP;
#pragma unroll
                for (int bj = 0; bj < 2; ++bj) { const f32x4 v0 = acc[ai][bj][m][0] * rs, v1 = acc[ai][bj][m][1] * rs;
                    u32x4 w; w.x = pk2(v0[0], v0[1]); w.y = pk2(v0[2], v0[3]); w.z = pk2(v1[0], v1[1]); w.w = pk2(v1[2], v1[3]); *(u32x4*)(SG + (size_t)sr * UPC + bj * DFF + c8) = w;
                    if (bj == 0 && (sr & 31) >= 30) { float* dst = fcs + ((size_t)(sr >> 5) * 2 + ((sr & 31) - 30)) * DFF + c8; *(f32x4*)dst = v0; *(f32x4*)(dst + 4) = v1; } }
            EPI_ROWS_END
            return;
        }
        const int src1 = (fq << 4) | ((fr + 15) & 15), src2 = (fq << 4) | ((fr + 14) & 15);
#pragma unroll
        for (int n = 0; n < 2; ++n) {
            const int c4 = c8 + 4 * n;
            const f32x4 w0 = *(const f32x4*)(cw + c4), w1 = *(const f32x4*)(cw + DFF + c4), w2 = *(const f32x4*)(cw + 2 * DFF + c4), cbv = *(const f32x4*)(cb + c4);
#pragma unroll
            for (int ai = 0; ai < 2; ++ai) {
                f32x4 pg = {0.f, 0.f, 0.f, 0.f};
#pragma unroll
                for (int m = 0; m < 4; ++m) { const int row = u.pm * BM + ai * HALF + wr * 64 + m * 16 + fr;
                    const float rs = rstd_of(acc_get_i(ssq, (unsigned)row, 1.0f / SSQ_SCALE), 1.0f / DM);
                    const f32x4 g = acc[ai][0][m][n] * rs, up = acc[ai][1][m][n] * rs;
                    f32x4 a;
#pragma unroll
                    for (int j = 0; j < 4; ++j) { const float s1 = __shfl(fr == 15 ? pg[j] : g[j], src1), s2 = __shfl(fr >= 14 ? pg[j] : g[j], src2);
                        a[j] = silu_f(cbv[j] + w0[j] * s2 + w1[j] * s1 + w2[j] * g[j]) * up[j]; }
                    u32x2 gw; gw.x = pk2(g[0], g[1]); gw.y = pk2(g[2], g[3]);
                    if (m == 0 && fr < 2) {
                        *boff((u32x2*)GS, (unsigned)(((row >> 6) * 4 + 2 + fr) * DFF + c4) * 2u) = gw;
                        u32x2 uw; uw.x = pk2(up[0], up[1]); uw.y = pk2(up[2], up[3]); *boff((u32x2*)US, (unsigned)(((row >> 6) * 2 + fr) * DFF + c4) * 2u) = uw;
                    } else { u32x2 w; w.x = pk2(a[0], a[1]); w.y = pk2(a[2], a[3]); *boff((u32x2*)A2, (unsigned)(row * DFF + c4) * 2u) = w; }
                    if (m == 3 && fr >= 14) {
                        *boff((u32x2*)GS, (unsigned)(((row >> 6) * 4 + (fr - 14)) * DFF + c4) * 2u) = gw;
                        if ((row & (SEQ - 1)) >= SEQ - 2) *boff((f32x4*)fcp, (unsigned)(((row >> 11) * 2 + ((row & (SEQ - 1)) - (SEQ - 2))) * DFF + c4) * 4u) = g;
                    }
                    pg = g;
                    asm volatile("" ::: "memory");
                }
            }
        }
    }
};

}
template <bool UPMAP = false>
DI void transpose_item(const float* W, int K, int N, bf16_t* WT, const float* gain, LAS float* scr, int item, int lane) {
    const int nblk = N / 32, kb = item / nblk, nb = item % nblk, k0 = 64 * kb, n0 = 32 * nb;
    const int r0 = !UPMAP ? n0 : (n0 < DFF ? ((n0 >> 7) << 8) + (n0 & 127) : (((n0 - DFF) >> 7) << 8) + 128 + ((n0 - DFF) & 127));
#pragma unroll
    for (int i = 0; i < 32; ++i) { const int kk = 2 * i + (lane >> 5); float v = W[(size_t)(k0 + kk) * N + n0 + (lane & 31)]; if (gain) v *= gain[k0 + kk]; scr[kk * 33 + (lane & 31)] = v; }
    asm volatile("s_waitcnt lgkmcnt(0)" ::: "memory");
    const int c = lane & 7;
#pragma unroll
    for (int j = 0; j < 4; ++j) { const int n = (lane >> 3) + 8 * j; const LAS float* s = scr + (8 * c) * 33 + n;
        u32x4 o; o.x = pk2(s[0 * 33], s[1 * 33]); o.y = pk2(s[2 * 33], s[3 * 33]); o.z = pk2(s[4 * 33], s[5 * 33]); o.w = pk2(s[6 * 33], s[7 * 33]);
        *(u32x4*)(WT + (size_t)(r0 + n) * K + k0 + 8 * c) = o; }
    asm volatile("s_waitcnt lgkmcnt(0)" ::: "memory");
}
template <bool UPMAP = false>
DI void convert_matrix(const float* W, int K, int N, bf16_t* WT, const float* gain, LAS float* scr, int gw, int ngw, int lane) {
    const int nitems = (K / 64) * (N / 32);
    for (int it = gw; it < nitems; it += ngw) transpose_item<UPMAP>(W, K, N, WT, gain, scr, it, lane);
}

DI void convert_layer_weights(int l, int part, LAS float* scr, int gw, int ngw, int lane) {
    bf16_t* wl = (bf16_t*)(kparams()->ws + WS_W) + (size_t)l * WL_STRIDE;
    if (part < 0 || part == 0) {
        { KParams p = kparams(); convert_matrix(p->in[9] + (size_t)l * DM * INC, DM, INC, wl + WL_IN, p->in[8] + l * DM, scr, gw, ngw, lane); }
        { KParams p = kparams(); convert_matrix(p->in[20] + (size_t)l * DM * DM, DM, DM, wl + WL_OUT, nullptr, scr, gw, ngw, lane); } }
    if (part < 0 || part == 1) {
        { KParams p = kparams(); convert_matrix(p->in[23] + (size_t)l * DM * DM, DM, DM, wl + WL_Q, p->in[21] + l * DM, scr, gw, ngw, lane); }
        { KParams p = kparams(); convert_matrix(p->in[24] + (size_t)l * DM * DM, DM, DM, wl + WL_K, p->in[22] + l * DM, scr, gw, ngw, lane); }
        { KParams p = kparams(); convert_matrix(p->in[25] + (size_t)l * DM * DM, DM, DM, wl + WL_V, p->in[22] + l * DM, scr, gw, ngw, lane); }
        { KParams p = kparams(); convert_matrix(p->in[26] + (size_t)l * DM * DM, DM, DM, wl + WL_O, nullptr, scr, gw, ngw, lane); } }
    if (part < 0 || part == 2) {
        { KParams p = kparams(); convert_matrix<true>(p->in[30] + (size_t)l * DM * UPC, DM, UPC, wl + WL_UP, p->in[29] + l * DM, scr, gw, ngw, lane); }
        { KParams p = kparams(); convert_matrix(p->in[33] + (size_t)l * DFF * DM, DFF, DM, wl + WL_DN, nullptr, scr, gw, ngw, lane); } }
}
DI void phase_prologue(LAS unsigned char* lds, int gw, int ngw, int wid, int lane) {
    LAS float* scr = (LAS float*)(lds + wid * 16384);
    convert_layer_weights(0, -1, scr, gw, ngw, lane);
    KParams p = kparams();
    acc_t* ssq = (acc_t*)(p->ws + WS_SSQ); bf16_t* XB = (bf16_t*)(p->ws + WS_XB);
    const float* xp = p->in[0]; const float* xs = p->in[1];
    for (int row0 = gw; row0 < R; row0 += 4 * ngw) {
        f32x4 v[4][4];
#pragma unroll
        for (int i = 0; i < 4; ++i) { const int row = row0 + i * ngw; if (row < R) { const float* src = row < RP ? xp + (size_t)row * DM : xs + (size_t)(row - RP) * DM;
#pragma unroll
            for (int j = 0; j < 4; ++j) v[i][j] = *(const f32x4*)(src + 4 * lane + 256 * j); } }
#pragma unroll
        for (int i = 0; i < 4; ++i) { const int row = row0 + i * ngw; if (row < R) { float ss = 0.f;
#pragma unroll
            for (int j = 0; j < 4; ++j) { const f32x4 x = v[i][j]; u32x2 w; w.x = pk2(x[0], x[1]); w.y = pk2(x[2], x[3]); *(u32x2*)(XB + (size_t)row * DM + 4 * lane + 256 * j) = w;
                ss += (x[0] * x[0] + x[1] * x[1]) + (x[2] * x[2] + x[3] * x[3]); }
            ss = wave_sum(ss); if (lane == 0) ssq[row] = (acc_t)(ss * SSQ_SCALE); } }
    }
    float* ssqm = (float*)(p->ws + WS_SSQM); bf16_t* MB = (bf16_t*)(p->ws + WS_MB);
    for (int row = gw; row < MEMR; row += ngw) {
        const float* src = p->in[7] + (size_t)row * DM; float ss = 0.f;
#pragma unroll
        for (int j = 0; j < 4; ++j) { const f32x4 v = *(const f32x4*)(src + 4 * lane + 256 * j);
            u32x2 w; w.x = pk2(v[0], v[1]); w.y = pk2(v[2], v[3]); *(u32x2*)(MB + (size_t)row * DM + 4 * lane + 256 * j) = w;
            ss += (v[0] * v[0] + v[1] * v[1]) + (v[2] * v[2] + v[3] * v[3]); }
        ss = wave_sum(ss); if (lane == 0) ssqm[row] = ss;
    }
    for (int i = R + gw * 64 + lane; i < DEPTH * 3 * R; i += ngw * 64) ssq[i] = 0ull;
}

DI void qk_post_row(bf16_t* Z, int row, const u32x4 w0, const u32x4 w1, const float* qg, const float* kg, float* dkp, float* dks, int lane) {
    bf16_t* ptr = Z + (size_t)row * INC + lane * 16;
    float a[8], b[8]; unpack8(w0, a); unpack8(w1, b);
    float ss = 0.f;
#pragma unroll
    for (int i = 0; i < 8; ++i) ss += a[i] * a[i] + b[i] * b[i];
    ss += __shfl_xor(ss, 1); ss += __shfl_xor(ss, 2);
    const float rs = rstd_of(ss, 1.0f / 64.f);
    const bool isq = lane < 32;
    const float* g = (isq ? qg : kg) + (lane & 3) * 16;
#pragma unroll
    for (int i = 0; i < 8; ++i) { a[i] *= rs * g[i]; b[i] *= rs * g[8 + i]; }
    const int pos = row < RP ? (row & (SEQ - 1)) : PAST + ((row - RP) & (DSEQ - 1));
    if ((lane & 3) == 0) {
        const float fp = (float)pos;
        const float hi[8] = {1.5905761719e-01f, 3.0853271484e-02f, 5.9814453125e-03f, 1.1606216431e-03f, 2.2506713867e-04f, 4.3630599976e-05f, 8.4638595581e-06f, 1.6409903765e-06f};
        const float lo[8] = {9.7325901152e-05f, 1.0491919966e-05f, 3.7404001887e-06f, 4.1998173828e-08f, 1.1940367806e-08f, 1.7352817849e-08f, 4.7125015001e-10f, 4.3588632703e-10f};
#pragma unroll
        for (int i = 0; i < 8; ++i) {
            float t = fp * hi[i]; t = t - rintf(t); t += fp * lo[i];
            const float sn = __builtin_amdgcn_sinf(t), cs = __builtin_amdgcn_cosf(t);
            const float x1 = a[i], x2 = b[i]; a[i] = x1 * cs - x2 * sn; b[i] = x2 * cs + x1 * sn; }
    }
    if (!isq) {
        float* dst = (row < RP ? dkp + (size_t)row * 512 : dks + (size_t)(row - RP) * 512) + (lane - 32) * 16;
        *(f32x4*)dst = (f32x4){a[0], a[1], a[2], a[3]}; *(f32x4*)(dst + 4) = (f32x4){a[4], a[5], a[6], a[7]};
        *(f32x4*)(dst + 8) = (f32x4){b[0], b[1], b[2], b[3]}; *(f32x4*)(dst + 12) = (f32x4){b[4], b[5], b[6], b[7]};
    } else {
#pragma unroll
        for (int i = 0; i < 8; ++i) { a[i] *= QSCALE; b[i] *= QSCALE; }
    }
    *(u32x4*)ptr = pack8(a); *(u32x4*)(ptr + 8) = pack8(b);
}
DI void qk_post_rows(bf16_t* Z, int gw, int ngw, const float* qg, const float* kg, float* dkp, float* dks, int lane) {
    for (int row = gw; row < R; row += 8 * ngw) {
        u32x4 w0[8], w1[8];
#pragma unroll
        for (int i = 0; i < 8; ++i) { const int r = row + i * ngw; if (r < R) { const bf16_t* ptr = Z + (size_t)r * INC + lane * 16; w0[i] = *(const u32x4*)ptr; w1[i] = *(const u32x4*)(ptr + 8); } }
#pragma unroll
        for (int i = 0; i < 8; ++i) { const int r = row + i * ngw; if (r < R) qk_post_row(Z, r, w0[i], w1[i], qg, kg, dkp, dks, lane); }
    }
}
DI void memk_post_row(bf16_t* MK, int row, const u32x4 w0, const u32x4 w1, const float* xkg, const float* xqg, float* mkp, int lane) {
    bf16_t* ptr = MK + (size_t)row * DM + lane * 16;
    float a[8], b[8]; unpack8(w0, a); unpack8(w1, b);
    float ss = 0.f;
#pragma unroll
    for (int i = 0; i < 8; ++i) ss += a[i] * a[i] + b[i] * b[i];
    ss += __shfl_xor(ss, 1); ss += __shfl_xor(ss, 2); ss += __shfl_xor(ss, 4); ss += __shfl_xor(ss, 8);
    const float rs = rstd_of(ss, 1.0f / 256.f);
    const int d0 = (lane & 15) * 16;
#pragma unroll
    for (int i = 0; i < 8; ++i) { a[i] *= rs * xkg[d0 + i]; b[i] *= rs * xkg[d0 + 8 + i]; }
    float* dst = mkp + (size_t)row * DM + lane * 16;
    *(f32x4*)dst = (f32x4){a[0], a[1], a[2], a[3]}; *(f32x4*)(dst + 4) = (f32x4){a[4], a[5], a[6], a[7]};
    *(f32x4*)(dst + 8) = (f32x4){b[0], b[1], b[2], b[3]}; *(f32x4*)(dst + 12) = (f32x4){b[4], b[5], b[6], b[7]};
#pragma unroll
    for (int i = 0; i < 8; ++i) { a[i] *= xqg[d0 + i]; b[i] *= xqg[d0 + 8 + i]; }
    *(u32x4*)ptr = pack8(a); *(u32x4*)(ptr + 8) = pack8(b);
}

DI void memk_post_rows(bf16_t* MK, int gw, int ngw, const float* xkg, const float* xqg, float* mkp, int lane) {
    for (int row = gw; row < MEMR; row += 4 * ngw) {
        u32x4 w0[4], w1[4];
#pragma unroll
        for (int i = 0; i < 4; ++i) { const int r = row + i * ngw; if (r < MEMR) { const bf16_t* ptr = MK + (size_t)r * DM + lane * 16; w0[i] = *(const u32x4*)ptr; w1[i] = *(const u32x4*)(ptr + 8); } }
#pragma unroll
        for (int i = 0; i < 4; ++i) { const int r = row + i * ngw; if (r < MEMR) memk_post_row(MK, r, w0[i], w1[i], xkg, xqg, mkp, lane); }
    }
}

#define MFMA32(a, b, c) __builtin_amdgcn_mfma_f32_32x32x16_bf16((a), (b), (c), 0, 0, 0)
DI int crow(int r, int hi) { return (r & 3) + 8 * (r >> 2) + 4 * hi; }

DI void gate_unit(int un, int& cached_g, const bf16_t* Z, bf16_t* H, const float* Wsl, const float* gmb, const float* gmg, LAS unsigned char* lds, int tid, int wid, int lane) {
    const int b = un >> 6, n = (un >> 2) & 15, g = un & 3, row0 = b * SEQ + n * 128;
    LAS unsigned char* Ws = lds; LAS unsigned char* Gt = lds + 128 * 272;
    const int r32 = lane & 31, hi = lane >> 5, tblk = wid & 3, cp = wid >> 2;
    const int t = tblk * 32 + r32, row = row0 + t; const float bias = gmb[g * 128 + t];
    u32x2 uw[2][4];
#pragma unroll
    for (int cc = 0; cc < 2; ++cc)
#pragma unroll
        for (int rg = 0; rg < 4; ++rg) uw[cc][rg] = *(const u32x2*)(Z + (size_t)row * INC + 1536 + g * 128 + (2 * cp + cc) * 32 + 8 * rg + 4 * hi);
    if (g != cached_g) {
        cached_g = g;
        const float* wsrc = Wsl + (size_t)g * 128 * 128;
#pragma unroll
        for (int i = 0; i < 8; ++i) { const int idx = tid + NTHR * i, t = idx >> 5, s4 = (idx & 31) * 4; f32x4 v = *(const f32x4*)(wsrc + t * 128 + s4);
#pragma unroll
            for (int j = 0; j < 4; ++j) if (s4 + j > t) v[j] = 0.f;
            u32x2 w; w.x = pk2(v[0], v[1]); w.y = pk2(v[2], v[3]); *(LAS u32x2*)(Ws + t * 272 + s4 * 2) = w; }
    }
#pragma unroll
    for (int i = 0; i < 4; ++i) { const int idx = tid + NTHR * i, s = idx >> 4, ch = idx & 15;
        const u32x4 w = *(const u32x4*)(Z + (size_t)(row0 + s) * INC + 2048 + g * 128 + ch * 8); float v[8]; unpack8(w, v);
        float ss = 0.f;
#pragma unroll
        for (int j = 0; j < 8; ++j) ss += v[j] * v[j];
        ss += __shfl_xor(ss, 1); ss += __shfl_xor(ss, 2); ss += __shfl_xor(ss, 4); ss += __shfl_xor(ss, 8);
        const float rs = rstd_of(ss, 1.0f / 128.f);
#pragma unroll
        for (int j = 0; j < 8; j += 2) { const unsigned pw = pk2(v[j] * rs * gmg[ch * 8 + j], v[j + 1] * rs * gmg[ch * 8 + j + 1]);
            *(LAS bf16_t*)(Gt + (ch * 8 + j) * 272 + ((s ^ (ch << 3)) << 1)) = (bf16_t)(pw & 0xffffu); *(LAS bf16_t*)(Gt + (ch * 8 + j + 1) * 272 + ((s ^ (ch << 3)) << 1)) = (bf16_t)(pw >> 16); } }
    __syncthreads();
    f32x16 acc[2];
#pragma unroll
    for (int i = 0; i < 16; ++i) { acc[0][i] = 0.f; acc[1][i] = 0.f; }
    const int nks = 2 * (tblk + 1);
    for (int ks = 0; ks < nks; ++ks) {
        const bf16x8 bf = *(const LAS bf16x8*)(Ws + (tblk * 32 + r32) * 272 + (ks * 16 + hi * 8) * 2);
#pragma unroll
        for (int cc = 0; cc < 2; ++cc) { const int crow_ = (2 * cp + cc) * 32 + r32; const bf16x8 af = *(const LAS bf16x8*)(Gt + crow_ * 272 + (((ks * 2 + hi) ^ (crow_ >> 3)) << 4)); acc[cc] = MFMA32(af, bf, acc[cc]); }
    }
#pragma unroll
    for (int cc = 0; cc < 2; ++cc)
#pragma unroll
        for (int rg = 0; rg < 4; ++rg) { const int c0 = (2 * cp + cc) * 32 + 8 * rg + 4 * hi;
            const u32x2 uv = uw[cc][rg];
            u32x2 o; o.x = pk2(bflo(uv.x) * (acc[cc][4 * rg] + bias), bfhi(uv.x) * (acc[cc][4 * rg + 1] + bias)); o.y = pk2(bflo(uv.y) * (acc[cc][4 * rg + 2] + bias), bfhi(uv.y) * (acc[cc][4 * rg + 3] + bias));
            *(u32x2*)(H + (size_t)row * DM + 512 + g * 128 + c0) = o; }
    __syncthreads();
}
DI void gate_sample_unit(int un, const bf16_t* Z, bf16_t* H, const float* Wsl, const float* gmb, const float* gmg, float* gvs, LAS unsigned char* lds, int tid, int wid, int lane) {
    const int b = un >> 2, g = un & 3, row0 = RP + b * DSEQ;
    LAS float* gvn = (LAS float*)lds;
    for (int s = wid; s < DSEQ; s += NWAVES) {
        const unsigned w = *(const unsigned*)(Z + (size_t)(row0 + s) * INC + 2048 + g * 128 + 2 * lane);
        const float v0 = bflo(w), v1 = bfhi(w); const float ss = wave_sum(v0 * v0 + v1 * v1); const float rs = rstd_of(ss, 1.0f / 128.f);
        const float n0 = v0 * rs * gmg[2 * lane], n1 = v1 * rs * gmg[2 * lane + 1];
        gvn[s * 128 + 2 * lane] = n0; gvn[s * 128 + 2 * lane + 1] = n1;
        *(f32x2*)(gvs + (size_t)(b * DSEQ + s) * 512 + g * 128 + 2 * lane) = (f32x2){n0, n1};
    }
    LAS float* wl_ = gvn + DSEQ * 128;
    for (int i = tid; i < DSEQ * DSEQ; i += NTHR) wl_[(i >> 5) * 33 + (i & 31)] = Wsl[(size_t)g * 128 * 128 + (i >> 5) * 128 + (i & 31)];
    __syncthreads();
#pragma unroll
    for (int k = 0; k < 8; ++k) { const int idx = tid + NTHR * k, t = idx >> 7, c = idx & 127; float acc = 0.f;
        const LAS float* wr_ = wl_ + t * 33;
#pragma unroll 4
        for (int s = 0; s < DSEQ; ++s) acc += (s <= t ? wr_[s] : 0.f) * gvn[s * 128 + c];
        const float uu = bflo((unsigned)Z[(size_t)(row0 + t) * INC + 1536 + g * 128 + c]);
        const unsigned pw = pk2(uu * (acc + gmb[g * 128 + t]), 0.f);
        H[(size_t)(row0 + t) * DM + 512 + g * 128 + c] = (bf16_t)(pw & 0xffffu); }
    __syncthreads();
}

DI void diff_attn_unit(int b, int h, int qb, const bf16_t* Z, const bf16_t* VT, bf16_t* H, float lam, const float* subg, float oscale, LAS unsigned char* lds, int wid, int lane) {
    const int r32 = lane & 31, hi = lane >> 5, mp = wid >> 2, wq = wid & 3;
    const int qrow = b * SEQ + qb * 128 + wq * 32 + r32;
    bf16x8 qf[4];
#pragma unroll
    for (int ks = 0; ks < 4; ++ks) qf[ks] = *(const bf16x8*)(Z + (size_t)qrow * INC + h * 128 + mp * 64 + ks * 16 + hi * 8);
    const int ntile = 2 * qb + 2, mylast = 2 * qb + (wq >> 1);
    const bf16_t* kg[2]; const bf16_t* vg[2];
#pragma unroll
    for (int i = 0; i < 2; ++i) { const int q = i * 8 + wid;
        { const int row = 4 * q + (lane >> 4), c = (lane & 15) ^ (row & 15); kg[i] = Z + (size_t)(b * SEQ + row) * INC + 512 + h * 128 + c * 8; }
        { const int row = 8 * q + (lane >> 3), c = (lane & 7) ^ (row & 7); vg[i] = VT + (size_t)((b * 4 + h) * 128 + row) * SEQ + c * 8; } }
#define DA_ISSUE(t, buf) do { _Pragma("unroll") for (int i_ = 0; i_ < 2; ++i_) { \
        __builtin_amdgcn_global_load_lds((const unsigned*)(kg[i_] + (size_t)(t) * 64 * INC), (LAS unsigned*)(lds + (buf) * 32768 + (i_ * 8 + wid) * 1024), 16, 0, 0); \
        __builtin_amdgcn_global_load_lds((const unsigned*)(vg[i_] + (size_t)(t) * 64), (LAS unsigned*)(lds + (buf) * 32768 + 16384 + (i_ * 8 + wid) * 1024), 16, 0, 0); } } while (0)
    f32x16 O[4];
#pragma unroll
    for (int d = 0; d < 4; ++d)
#pragma unroll
        for (int i = 0; i < 16; ++i) O[d][i] = 0.f;
    float ls = 0.f;
    DA_ISSUE(0, 0);
    asm volatile("s_waitcnt vmcnt(0)" ::: "memory"); __syncthreads();
    for (int t = 0; t < ntile; ++t) {
        const int buf = t & 1;
        if (t + 1 < ntile) DA_ISSUE(t + 1, buf ^ 1);
        if (t <= mylast) {
            const LAS unsigned char* kb = lds + buf * 32768; const LAS unsigned char* vb = kb + 16384;
            f32x16 s0, s1;
#pragma unroll
            for (int i = 0; i < 16; ++i) { s0[i] = 0.f; s1[i] = 0.f; }
#pragma unroll
            for (int ks = 0; ks < 4; ++ks) { const int c = mp * 8 + ks * 2 + hi; const int off = r32 * 256 + ((c ^ (r32 & 15)) << 4);
                const bf16x8 a0 = *(const LAS bf16x8*)(kb + off), a1 = *(const LAS bf16x8*)(kb + 8192 + off);
                s0 = MFMA32(a0, qf[ks], s0); s1 = MFMA32(a1, qf[ks], s1); }
#pragma unroll
            for (int i = 0; i < 16; ++i) { s0[i] = __builtin_amdgcn_exp2f(s0[i]); s1[i] = __builtin_amdgcn_exp2f(s1[i]); ls += s0[i] + s1[i]; }
            bf16x8 pb[4]; u32x4 w;
            w.x = pk2(s0[0], s0[1]); w.y = pk2(s0[2], s0[3]); w.z = pk2(s0[4], s0[5]); w.w = pk2(s0[6], s0[7]); pb[0] = __builtin_bit_cast(bf16x8, w);
            w.x = pk2(s0[8], s0[9]); w.y = pk2(s0[10], s0[11]); w.z = pk2(s0[12], s0[13]); w.w = pk2(s0[14], s0[15]); pb[1] = __builtin_bit_cast(bf16x8, w);
            w.x = pk2(s1[0], s1[1]); w.y = pk2(s1[2], s1[3]); w.z = pk2(s1[4], s1[5]); w.w = pk2(s1[6], s1[7]); pb[2] = __builtin_bit_cast(bf16x8, w);
            w.x = pk2(s1[8], s1[9]); w.y = pk2(s1[10], s1[11]); w.z = pk2(s1[12], s1[13]); w.w = pk2(s1[14], s1[15]); pb[3] = __builtin_bit_cast(bf16x8, w);
#pragma unroll
            for (int d = 0; d < 4; ++d)
#pragma unroll
                for (int j = 0; j < 4; ++j) { const int row = 32 * d + r32; const LAS unsigned char* rp = vb + row * 128 + 8 * hi;
                    const u32x2 lo = *(const LAS u32x2*)(rp + (((2 * j) ^ (row & 7)) << 4)), hh = *(const LAS u32x2*)(rp + (((2 * j + 1) ^ (row & 7)) << 4));
                    const u32x4 wv = {lo.x, lo.y, hh.x, hh.y}; const bf16x8 a = __builtin_bit_cast(bf16x8, wv);
                    O[d] = MFMA32(a, pb[j], O[d]); }
        }
        asm volatile("s_waitcnt vmcnt(0)" ::: "memory"); __syncthreads();
    }
#undef DA_ISSUE
    ls += __shfl_xor(ls, 32);
    LAS float* xch = (LAS float*)(lds + wq * 16384);
    if (mp == 1) { const float i1 = lam / ls;
#pragma unroll
        for (int d = 0; d < 4; ++d)
#pragma unroll
            for (int i = 0; i < 16; ++i) xch[(d * 16 + i) * 64 + lane] = O[d][i] * i1; }
    __syncthreads();
    if (mp == 0) { const float i0 = 1.0f / ls; float ss = 0.f;
#pragma unroll
        for (int d = 0; d < 4; ++d)
#pragma unroll
            for (int i = 0; i < 16; ++i) { const float o = O[d][i] * i0 - xch[(d * 16 + i) * 64 + lane]; O[d][i] = o; ss += o * o; }
        ss += __shfl_xor(ss, 32);
        const float rs = rstd_of(ss, 1.0f / 128.f) * oscale;
        bf16_t* hp = H + (size_t)qrow * DM + h * 128;
#pragma unroll
        for (int d = 0; d < 4; ++d)
#pragma unroll
            for (int rg = 0; rg < 4; ++rg) { const int d0 = 32 * d + 8 * rg + 4 * hi; const f32x4 g4 = *(const f32x4*)(subg + d0);
                u32x2 o; o.x = pk2(O[d][4 * rg] * rs * g4[0], O[d][4 * rg + 1] * rs * g4[1]); o.y = pk2(O[d][4 * rg + 2] * rs * g4[2], O[d][4 * rg + 3] * rs * g4[3]);
                *(u32x2*)(hp + d0) = o; } }
    __syncthreads();
}

DI void diff_attn_sample_pair(int it, int hf, int l, const float* cdk, const float* cdv, const float* outp, const bf16_t* Z, bf16_t* H, float lam, const float* subg, float oscale, LAS unsigned char* lds, int wid, int lane) {
    const int srow = it >> 2, h = it & 3, b = srow >> 5;
    LAS float* qs = (LAS float*)(lds + wid * 16384);
    LAS float* ps = qs + 128; LAS float* xst = ps + 2 * 544; LAS float* xacc = xst + 4;
    const LAS float* ost = (const LAS float*)(lds + (wid ^ 1) * 16384) + 128 + 2 * 544; const LAS float* oacc = ost + 4;
    const int NKH = 544, nkl = hf ? 544 : 512, j0g = hf * 512;
    { const unsigned w = *(const unsigned*)(Z + (size_t)(RP + srow) * INC + h * 128 + 2 * lane); qs[2 * lane] = bflo(w); qs[2 * lane + 1] = bfhi(w); }
    asm volatile("s_waitcnt lgkmcnt(0)" ::: "memory");
    const float* ck = cdk + (size_t)(l * DB + b) * PAST * 512 + h * 128;
    const float* nk = outp + O_DKS + (size_t)(l * DB + b) * DSEQ * 512 + h * 128;
    float mx[2] = {-3.0e38f, -3.0e38f};
    for (int jj = lane; jj < nkl; jj += 64) { const int j = j0g + jj;
        const float* kp = j < PAST ? ck + (size_t)j * 512 : nk + (size_t)(j - PAST) * 512;
#pragma unroll
        for (int m = 0; m < 2; ++m) { float dot = 0.f;
#pragma unroll
            for (int d = 0; d < 64; d += 4) { const f32x4 kv = *(const f32x4*)(kp + m * 64 + d); dot += kv[0] * qs[m * 64 + d] + kv[1] * qs[m * 64 + d + 1] + kv[2] * qs[m * 64 + d + 2] + kv[3] * qs[m * 64 + d + 3]; }
            ps[m * NKH + jj] = dot; mx[m] = fmaxf(mx[m], dot); }
    }
    float lsum[2], mm[2];
#pragma unroll
    for (int m = 0; m < 2; ++m) { mm[m] = wave_max(mx[m]); float s = 0.f;
        for (int jj = lane; jj < nkl; jj += 64) { const float e = __builtin_amdgcn_exp2f(ps[m * NKH + jj] - mm[m]); ps[m * NKH + jj] = e; s += e; }
        lsum[m] = wave_sum(s); }
    asm volatile("s_waitcnt lgkmcnt(0)" ::: "memory");
    const float* cv = cdv + (size_t)(l * DB + b) * PAST * 512 + h * 128 + 2 * lane;
    const float* nv = outp + O_DVS + (size_t)(l * DB + b) * DSEQ * 512 + h * 128 + 2 * lane;
    f32x2 a0 = {0.f, 0.f}, a1 = {0.f, 0.f};
#pragma unroll 1
    for (int jb = 0; jb < nkl; jb += 32) {
        const float* vp = (j0g + jb) < PAST ? cv + (size_t)(j0g + jb) * 512 : nv + (size_t)(j0g + jb - PAST) * 512;
        f32x2 v[32];
#pragma unroll
        for (int j = 0; j < 32; ++j) v[j] = *(const f32x2*)(vp + (size_t)j * 512);
#pragma unroll
        for (int j = 0; j < 32; ++j) { a0 += v[j] * ps[jb + j]; a1 += v[j] * ps[NKH + jb + j]; }
    }
    if (lane == 0) { xst[0] = mm[0]; xst[1] = mm[1]; xst[2] = lsum[0]; xst[3] = lsum[1]; }
    *(LAS f32x4*)(xacc + 4 * lane) = (f32x4){a0[0], a0[1], a1[0], a1[1]};
    __syncthreads();
    { const float om0 = ost[0], om1 = ost[1], ol0 = ost[2], ol1 = ost[3]; const f32x4 oa = *(const LAS f32x4*)(oacc + 4 * lane);
      const float M0 = fmaxf(mm[0], om0), M1 = fmaxf(mm[1], om1);
      const float f0 = __builtin_amdgcn_exp2f(mm[0] - M0), g0 = __builtin_amdgcn_exp2f(om0 - M0), f1 = __builtin_amdgcn_exp2f(mm[1] - M1), g1 = __builtin_amdgcn_exp2f(om1 - M1);
      const float l0 = hf ? ol0 * g0 + lsum[0] * f0 : lsum[0] * f0 + ol0 * g0, l1 = hf ? ol1 * g1 + lsum[1] * f1 : lsum[1] * f1 + ol1 * g1;
      const float n00 = hf ? oa[0] * g0 + a0[0] * f0 : a0[0] * f0 + oa[0] * g0, n01 = hf ? oa[1] * g0 + a0[1] * f0 : a0[1] * f0 + oa[1] * g0;
      const float n10 = hf ? oa[2] * g1 + a1[0] * f1 : a1[0] * f1 + oa[2] * g1, n11 = hf ? oa[3] * g1 + a1[1] * f1 : a1[1] * f1 + oa[3] * g1;
      const float i0 = 1.0f / l0, i1 = lam / l1;
      const float o0 = n00 * i0 - n10 * i1, o1 = n01 * i0 - n11 * i1;
      const float ss = wave_sum(o0 * o0 + o1 * o1); const float rs = rstd_of(ss, 1.0f / 128.f) * oscale;
      if (hf == 0) *(unsigned*)(H + (size_t)(RP + srow) * DM + h * 128 + 2 * lane) = pk2(o0 * rs * subg[2 * lane], o1 * rs * subg[2 * lane + 1]); }
}

DI void cross_attn_sample_pair(int it, int hf, int l, const float* cmk, const float* cmv, const bf16_t* Q, const acc_t* ssqq, const float* xqg, bf16_t* H, LAS unsigned char* lds, int wid, int lane) {
    const int srow = it >> 2, h = it & 3, b = srow >> 5, row = RP + srow;
    LAS float* qs = (LAS float*)(lds + wid * 16384);
    LAS float* ps = qs + 256; LAS float* xst = ps + 128; LAS float* xacc = xst + 4;
    const LAS float* ost = (const LAS float*)(lds + (wid ^ 1) * 16384) + 256 + 128; const LAS float* oacc = ost + 4;
    { const u32x2 w = *(const u32x2*)(Q + (size_t)row * DM + h * 256 + 4 * lane); const float rs = rstd_of(acc_get(ssqq + (size_t)row * 4 + h, 1.0f / SSQ_SCALE), 1.0f / 256.f) * XSCALE;
      const f32x4 g4 = *(const f32x4*)(xqg + 4 * lane);
      qs[4 * lane] = bflo(w.x) * rs * g4[0]; qs[4 * lane + 1] = bfhi(w.x) * rs * g4[1]; qs[4 * lane + 2] = bflo(w.y) * rs * g4[2]; qs[4 * lane + 3] = bfhi(w.y) * rs * g4[3]; }
    asm volatile("s_waitcnt lgkmcnt(0)" ::: "memory");
    const float* ck = cmk + ((size_t)(l * DB + b) * 256 + hf * 128) * DM + h * 256;
    float sc[2]; float mx = -3.0e38f;
#pragma unroll
    for (int k = 0; k < 2; ++k) { const float* kp = ck + (size_t)(lane + 64 * k) * DM; float dot = 0.f;
#pragma unroll 1
        for (int d0 = 0; d0 < 256; d0 += 64) { f32x4 kv[16];
#pragma unroll
            for (int d = 0; d < 16; ++d) kv[d] = *(const f32x4*)(kp + d0 + 4 * d);
#pragma unroll
            for (int d = 0; d < 16; ++d) dot += kv[d][0] * qs[d0 + 4 * d] + kv[d][1] * qs[d0 + 4 * d + 1] + kv[d][2] * qs[d0 + 4 * d + 2] + kv[d][3] * qs[d0 + 4 * d + 3]; }
        sc[k] = dot; mx = fmaxf(mx, dot); }
    mx = wave_max(mx); float s = 0.f;
#pragma unroll
    for (int k = 0; k < 2; ++k) { const float e = __builtin_amdgcn_exp2f(sc[k] - mx); ps[lane + 64 * k] = e; s += e; }
    s = wave_sum(s);
    asm volatile("s_waitcnt lgkmcnt(0)" ::: "memory");
    const float* cv = cmv + ((size_t)(l * DB + b) * 256 + hf * 128) * DM + h * 256 + 4 * lane;
    f32x4 acc = {0.f, 0.f, 0.f, 0.f};
#pragma unroll 1
    for (int jb = 0; jb < 128; jb += 16) { f32x4 v[16];
#pragma unroll
        for (int j = 0; j < 16; ++j) v[j] = *(const f32x4*)(cv + (size_t)(jb + j) * DM);
#pragma unroll
        for (int j = 0; j < 16; ++j) acc += v[j] * ps[jb + j]; }
    if (lane == 0) { xst[0] = mx; xst[1] = s; }
    *(LAS f32x4*)(xacc + 4 * lane) = acc;
    __syncthreads();
    { const float om = ost[0], os = ost[1]; const f32x4 oa = *(const LAS f32x4*)(oacc + 4 * lane);
      const float M = fmaxf(mx, om), f = __builtin_amdgcn_exp2f(mx - M), g = __builtin_amdgcn_exp2f(om - M);
      const float lt = hf ? os * g + s * f : s * f + os * g;
      const f32x4 n = hf ? oa * g + acc * f : acc * f + oa * g;
      const float inv = 1.0f / lt;
      if (hf == 0) { u32x2 o; o.x = pk2(n[0] * inv, n[1] * inv); o.y = pk2(n[2] * inv, n[3] * inv); *(u32x2*)(H + (size_t)row * DM + h * 256 + 4 * lane) = o; } }
}

DI void act_fix_item(int item, const bf16_t* GS, const bf16_t* US, bf16_t* A2, const float* cw, const float* cb) {
    const int cch = item % (DFF / 8), rest = item / (DFF / 8), f = rest & 1, k = rest >> 1, c0 = cch * 8, row = 64 * k + f;
    const bool seq_start = (k & 31) == 0;
    float gm2[8], gm1[8], g[8], up[8], a[8];
    if (f == 0) {
        if (seq_start) {
#pragma unroll
            for (int j = 0; j < 8; ++j) { gm2[j] = 0.f; gm1[j] = 0.f; } }
        else { unpack8(*(const u32x4*)(GS + ((size_t)(k - 1) * 4 + 0) * DFF + c0), gm2); unpack8(*(const u32x4*)(GS + ((size_t)(k - 1) * 4 + 1) * DFF + c0), gm1); }
        unpack8(*(const u32x4*)(GS + ((size_t)k * 4 + 2) * DFF + c0), g);
    } else {
        if (seq_start) {
#pragma unroll
            for (int j = 0; j < 8; ++j) gm2[j] = 0.f; }
        else unpack8(*(const u32x4*)(GS + ((size_t)(k - 1) * 4 + 1) * DFF + c0), gm2);
        unpack8(*(const u32x4*)(GS + ((size_t)k * 4 + 2) * DFF + c0), gm1); unpack8(*(const u32x4*)(GS + ((size_t)k * 4 + 3) * DFF + c0), g);
    }
    unpack8(*(const u32x4*)(US + ((size_t)k * 2 + f) * DFF + c0), up);
#pragma unroll
    for (int j = 0; j < 8; ++j) a[j] = silu_f(cb[c0 + j] + cw[c0 + j] * gm2[j] + cw[DFF + c0 + j] * gm1[j] + cw[2 * DFF + c0 + j] * g[j]) * up[j];
    *(u32x4*)(A2 + (size_t)row * DFF + c0) = pack8(a);
}
DI void act_sample_item(int item, const bf16_t* SG, bf16_t* A2s, const float* cw, const float* cb, const float* hist  ) {
    const int cch = item % (DFF / 8), sb = item / (DFF / 8), c0 = cch * 8;
    float w0[8], w1[8], w2[8], bb[8], g2[8], g1[8], g0[8], up[8];
#pragma unroll
    for (int j = 0; j < 8; ++j) { w0[j] = cw[c0 + j]; w1[j] = cw[DFF + c0 + j]; w2[j] = cw[2 * DFF + c0 + j]; bb[j] = cb[c0 + j]; }
    { const float* hp = hist + (size_t)sb * 2 * DFF + c0;
#pragma unroll
      for (int j = 0; j < 8; ++j) { g0[j] = hp[j]; g1[j] = hp[DFF + j]; } }
#pragma unroll 1
    for (int r0 = 0; r0 < DSEQ; r0 += 4) {
        u32x4 gw[4], uw[4];
#pragma unroll
        for (int i = 0; i < 4; ++i) { const bf16_t* gp = SG + (size_t)(sb * DSEQ + r0 + i) * UPC + c0; gw[i] = *(const u32x4*)gp; uw[i] = *(const u32x4*)(gp + DFF); }
#pragma unroll
        for (int i = 0; i < 4; ++i) { unpack8(gw[i], g2); unpack8(uw[i], up);
            float a[8];
#pragma unroll
            for (int j = 0; j < 8; ++j) { const float c = bb[j] + w0[j] * g0[j] + w1[j] * g1[j] + w2[j] * g2[j]; a[j] = silu_f(c) * up[j]; g0[j] = g1[j]; g1[j] = g2[j]; }
            *(u32x4*)(A2s + (size_t)(sb * DSEQ + r0 + i) * DFF + c0) = pack8(a); }
    }
}
#define XB_TMO      128
#define XB_XCNT(j)  (256  + 64 * (j))
#define XB_XSUB(j)  (1280 + 64 * (j))
#define XB_XGEN(j)  (2304 + 64 * (j))
#define XB_TOP      3328
#define XB_TOPGEN   3392
#define XCD_BAR_WORDS 3456
#define XB_SPIN_CAP (1u << 18)

DI unsigned xb_ld(unsigned* p)              { return __hip_atomic_load(p, __ATOMIC_RELAXED, __HIP_MEMORY_SCOPE_AGENT); }
DI unsigned xb_add(unsigned* p, unsigned v) { return __hip_atomic_fetch_add(p, v, __ATOMIC_RELAXED, __HIP_MEMORY_SCOPE_AGENT); }
DI unsigned xb_xcc_id() { return (unsigned)__builtin_amdgcn_s_getreg((3 << 11) | 20) & 0xFu; }
#define XB_SPIN(cond, bar) do { unsigned _sp = 0; while (cond) { __builtin_amdgcn_s_sleep(1); \
    if ((++_sp & 255u) == 0u) { if (xb_ld(&(bar)[XB_TMO])) break; if (_sp > XB_SPIN_CAP) { atomicAdd(&(bar)[XB_TMO], 1u); break; } } } } while (0)

struct XcdBarrier {
    unsigned* bar; unsigned x;
    volatile LAS unsigned* st;
};

DI bool xb_tid0(int wid) { return wid == 0 && __builtin_amdgcn_mbcnt_hi(~0u, __builtin_amdgcn_mbcnt_lo(~0u, 0u)) == 0u; }
DI XcdBarrier xcd_barrier_post(unsigned* bar, volatile LAS unsigned* st, int wid) {
    XcdBarrier b; b.bar = bar; b.x = xb_xcc_id(); b.st = st;
    if (xb_tid0(wid)) (void)xb_add(&bar[XB_XCNT(b.x)], 1u);
    return b;
}
DI void xcd_barrier_complete(unsigned* bar, unsigned x, unsigned& nloc, unsigned& nx) {
    const unsigned G = gridDim.x * gridDim.y * gridDim.z;
    unsigned sum, cnt, mine, sp = 0u;
    for (;;) {
        sum = 0u; cnt = 0u; mine = 0u;
#pragma unroll
        for (unsigned j = 0; j < 16; ++j) { const unsigned c = xb_ld(&bar[XB_XCNT(j)]); sum += c; cnt += (c > 0u) ? 1u : 0u; mine = (j == x) ? c : mine; }
        if (sum == G) break;
        __builtin_amdgcn_s_sleep(1);
        if ((++sp & 255u) == 0u) { if (xb_ld(&bar[XB_TMO])) break; if (sp > XB_SPIN_CAP) { atomicAdd(&bar[XB_TMO], 1u); break; } }
    }
    nloc = mine > 0u ? mine : 1u; nx = cnt > 0u ? cnt : 1u;
}

DI void xcd_barrier(const XcdBarrier& b, int wid) {
    asm volatile("s_waitcnt vmcnt(0)" ::: "memory");
    __syncthreads();
    if (xb_tid0(wid)) {
        unsigned* bar = b.bar;
        __builtin_amdgcn_s_waitcnt(0);
        unsigned nloc = b.st[0], nx = b.st[1];
        if (nloc == 0u) { xcd_barrier_complete(bar, b.x, nloc, nx); b.st[0] = nloc; b.st[1] = nx; }
        const unsigned old = xb_add(&bar[XB_XSUB(b.x)], 1u);
        const unsigned gen = old / nloc;
        if (old + 1u == (gen + 1u) * nloc) {
            __builtin_amdgcn_fence(__ATOMIC_RELEASE, "agent");
            asm volatile("s_waitcnt vmcnt(0)" ::: "memory");
            const unsigned og = xb_add(&bar[XB_TOP], 1u);
            const unsigned tg = og / nx;
            if (og + 1u == (tg + 1u) * nx) xb_add(&bar[XB_TOPGEN], 1u);
            else XB_SPIN(xb_ld(&bar[XB_TOPGEN]) == tg, bar);
            __builtin_amdgcn_fence(__ATOMIC_ACQUIRE, "agent");
            xb_add(&bar[XB_XGEN(b.x)], 1u);
            asm volatile("s_waitcnt vmcnt(0)" ::: "memory");
        } else {
            XB_SPIN(xb_ld(&bar[XB_XGEN(b.x)]) == gen, bar);
            __builtin_amdgcn_fence(__ATOMIC_ACQUIRE, "agent");
            asm volatile("s_waitcnt vmcnt(0)" ::: "memory");
        }
    }
    __syncthreads();
}

__global__ void __launch_bounds__(NTHR, 2) fwd_megakernel(Params p_unused) {
    extern __shared__ __attribute__((aligned(16))) unsigned char lds_raw[];
    LAS unsigned char* lds = (LAS unsigned char*)lds_raw;
    cg::grid_group grid = cg::this_grid();
    const int G = gridDim.x, bx = blockIdx.x, ngw = G * NWAVES;
const int wid_s = __builtin_amdgcn_readfirstlane((int)threadIdx.x >> 6);
#define LAUNDER_T int wid = wid_s; asm volatile("" : "+s"(wid)); unsigned m1_ = ~0u; asm volatile("" : "+s"(m1_)); const int lane = (int)__builtin_amdgcn_mbcnt_hi(m1_, __builtin_amdgcn_mbcnt_lo(m1_, 0u)); const int tid = (wid << 6) | lane, gw = bx * NWAVES + wid; (void)gw;
    { LAUNDER_T
      if (bx == 0) { unsigned* bw = (unsigned*)(kparams()->ws + WS_BAR); for (int i = tid; i < XCD_BAR_WORDS; i += NTHR) bw[i] = 0u; }
      if (tid < 2) ((LAS unsigned*)(lds + 131072 + 256))[tid] = 0u;
      phase_prologue(lds, gw, ngw, wid, lane); }
    grid.sync();
    XcdBarrier xbar = xcd_barrier_post((unsigned*)(kparams()->ws + WS_BAR), (volatile LAS unsigned*)(lds + 131072 + 256), wid_s);
#define GRID_SYNC() xcd_barrier(xbar, wid_s)

#define LAUNDER_L LAUNDER_T int l = l_; asm volatile("" : "+s"(l)); const KParams p = kparams(); unsigned char* ws = p->ws; float* outp = p->out; (void)outp;
#define WL ((const bf16_t*)(ws + WS_W) + (size_t)l * WL_STRIDE)
#define SSQ(n) ((acc_t*)(ws + WS_SSQ) + (size_t)(l * 3 + (n)) * R)
    for (int l_ = 0; l_ < DEPTH; ++l_) {
        { LAUNDER_L
          { pg8::SchedStd S; S.init((const bf16_t*)(ws + WS_XB), DM, WL + WL_IN, DM, R, INC, G, bx);
            pg8::EpiIn E{(bf16_t*)(ws + WS_Z), SSQ(0), outp + O_DVP + (size_t)l * RP * 512, outp + O_DVS + (size_t)l * RS * 512, (bf16_t*)(ws + WS_VT)}; pg8::gemm_phase(lds, tid, DM, DM, DM, S, E); }
          if (l == 0) { pg8::SchedStd S; S.init((const bf16_t*)(ws + WS_MB), DM, WL + WL_K, DM, MEMR, 2 * DM, G, bx);
            pg8::EpiKV E{(bf16_t*)(ws + WS_MK), (const float*)(ws + WS_SSQM), outp + O_MVP + (size_t)l * MEMR * DM, (bf16_t*)(ws + WS_MVT)}; pg8::gemm_phase(lds, tid, DM, DM, DM, S, E); } }
        GRID_SYNC();

        { LAUNDER_L
            bf16_t* Z = (bf16_t*)(ws + WS_Z); bf16_t* H = (bf16_t*)(ws + WS_H); bf16_t* MK = (bf16_t*)(ws + WS_MK);
            float* dkp = outp + O_DKP + (size_t)l * RP * 512; float* dks = outp + O_DKS + (size_t)l * RS * 512;
            float* mkp = outp + O_MKP + (size_t)l * MEMR * DM;
            const float* qg = p->in[10] + l * 64; const float* kg = p->in[11] + l * 64;
            qk_post_rows(Z, gw, ngw, qg, kg, dkp, dks, lane);
            memk_post_rows(MK, gw, ngw, p->in[28] + l * 256, p->in[27] + l * 256, mkp, lane);
            acc_t* ssqq = (acc_t*)(ws + WS_SSQQ); acc_t* lsum = (acc_t*)(ws + WS_LSUM);
            for (int i = gw * 64 + lane; i < R * 4; i += ngw * 64) ssqq[i] = 0ull;
            for (int i = gw * 64 + lane; i < RP * 4; i += ngw * 64) lsum[i] = 0ull;
            __syncthreads();
            const float* Wsl = p->in[18] + (size_t)l * 4 * 128 * 128; const float* gmb = p->in[19] + l * 512; const float* gmg = p->in[17] + l * 128;
            int cached_g = -1;
            for (int un = bx; un < NBATCH * 16 * 4; un += G) gate_unit(un, cached_g, Z, H, Wsl, gmb, gmg, lds, tid, wid, lane);
            for (int un = bx; un < DB * 4; un += G) gate_sample_unit(un, Z, H, Wsl, gmb, gmg, outp + O_GVS + (size_t)l * RS * 512, lds, tid, wid, lane);
        }
        GRID_SYNC();

        { LAUNDER_L
            const bf16_t* Z = (const bf16_t*)(ws + WS_Z); bf16_t* H = (bf16_t*)(ws + WS_H); const bf16_t* VT = (const bf16_t*)(ws + WS_VT);
            const float lam_init = lam_init_of(l);
            float lam;
            { const float a = wave_sum(p->in[12][l * 64 + lane] * p->in[13][l * 64 + lane]), b = wave_sum(p->in[14][l * 64 + lane] * p->in[15][l * 64 + lane]);
              lam = __builtin_bit_cast(float, __builtin_amdgcn_readfirstlane(__builtin_bit_cast(int, expf(a) - expf(b) + lam_init))); }
            const float* subg = p->in[16] + l * 128; const float oscale = 1.0f - lam_init;
            for (int pr = bx; pr < NBATCH * 4 * 8; pr += G) { const int bh = pr >> 3, s = pr & 7;
                diff_attn_unit(bh >> 2, bh & 3, s, Z, VT, H, lam, subg, oscale, lds, wid, lane);
                diff_attn_unit(bh >> 2, bh & 3, 15 - s, Z, VT, H, lam, subg, oscale, lds, wid, lane); }
            for (int base = bx * 4; base < RS * 4; base += G * 4) { diff_attn_sample_pair(base + (wid >> 1), wid & 1, l, p->in[2], p->in[3], outp, Z, H, lam, subg, oscale, lds, wid, lane); __syncthreads(); }
        }
        GRID_SYNC();

        { LAUNDER_L pg8::SchedStd S; S.init((const bf16_t*)(ws + WS_H), DM, WL + WL_OUT, DM, R, DM, G, bx); pg8::EpiRes E{nullptr, (bf16_t*)(ws + WS_XB), SSQ(1)}; pg8::gemm_phase(lds, tid, DM, DM, DM, S, E); }
        if (l_ + 1 < DEPTH && bx >= 4) { LAUNDER_T int ln = l_ + 1; asm volatile("" : "+s"(ln));
            convert_layer_weights(ln, 0, (LAS float*)(lds + wid * 16384), (bx - 4) * NWAVES + wid, (G - 4) * NWAVES, lane); }
        GRID_SYNC();

        { LAUNDER_L pg8::SchedStd S; S.init((const bf16_t*)(ws + WS_XB), DM, WL + WL_Q, DM, R, DM, G, bx); pg8::EpiQ E{(bf16_t*)(ws + WS_Q), SSQ(1), (acc_t*)(ws + WS_SSQQ)}; pg8::gemm_phase(lds, tid, DM, DM, DM, S, E); }
        if (l_ + 1 < DEPTH && bx >= 4) { LAUNDER_T int ln = l_ + 1; asm volatile("" : "+s"(ln));
            convert_layer_weights(ln, 1, (LAS float*)(lds + wid * 16384), (bx - 4) * NWAVES + wid, (G - 4) * NWAVES, lane); }
        GRID_SYNC();

        { LAUNDER_L
          { pg8::SchedX S{G, bx, (const char*)(ws + WS_Q), (const char*)(ws + WS_MK), (size_t)256 * DM * 2, (size_t)256 * 2}; pg8::EpiS E{(bf16_t*)(ws + WS_P), (const acc_t*)(ws + WS_SSQQ), (acc_t*)(ws + WS_LSUM)}; pg8::gemm_phase(lds, tid, 256, DM, DM, S, E); }
          for (int base = bx * 4; base < RS * 4; base += G * 4) { cross_attn_sample_pair(base + (wid >> 1), wid & 1, l, p->in[4], p->in[5], (const bf16_t*)(ws + WS_Q), (const acc_t*)(ws + WS_SSQQ), p->in[27] + l * 256, (bf16_t*)(ws + WS_H), lds, wid, lane); __syncthreads(); } }

        { LAUNDER_L pg8::SchedX S{G, bx, (const char*)(ws + WS_P), (const char*)(ws + WS_MVT), (size_t)DM * 256 * 2, (size_t)256 * 256 * 2}; pg8::EpiPV E{(bf16_t*)(ws + WS_H), (const acc_t*)(ws + WS_LSUM)}; pg8::gemm_phase(lds, tid, 256, DM, 256, S, E); }
        GRID_SYNC();

        { LAUNDER_L pg8::SchedStd S; S.init((const bf16_t*)(ws + WS_H), DM, WL + WL_O, DM, R, DM, G, bx); pg8::EpiRes E{nullptr, (bf16_t*)(ws + WS_XB), SSQ(2)}; pg8::gemm_phase(lds, tid, DM, DM, DM, S, E); }
        if (l_ + 1 < DEPTH && bx >= 4) { LAUNDER_T int ln = l_ + 1; asm volatile("" : "+s"(ln));
            convert_layer_weights(ln, 2, (LAS float*)(lds + wid * 16384), (bx - 4) * NWAVES + wid, (G - 4) * NWAVES, lane); }
        GRID_SYNC();

        { LAUNDER_L pg8::SchedStd S; S.init((const bf16_t*)(ws + WS_XB), DM, WL + WL_UP, DM, R, UPC, G, bx);
          pg8::EpiUpAct E{(bf16_t*)(ws + WS_A2), SSQ(2), (bf16_t*)(ws + WS_GS), (bf16_t*)(ws + WS_US), (bf16_t*)(ws + WS_SG), p->in[31] + (size_t)l * 3 * DFF, p->in[32] + (size_t)l * DFF,
                              outp + O_FCP + (size_t)l * NBATCH * 2 * DFF, outp + O_FCS + (size_t)l * DB * 2 * DFF}; pg8::gemm_phase(lds, tid, DM, DM, DM, S, E); }
        GRID_SYNC();

        { LAUNDER_L
            const float* cw = p->in[31] + (size_t)l * 3 * DFF; const float* cb = p->in[32] + (size_t)l * DFF; const float* hist = p->in[6] + (size_t)l * DB * 2 * DFF;
            for (int item = bx * NTHR + tid; item < (RP / 64) * 2 * (DFF / 8); item += G * NTHR) act_fix_item(item, (const bf16_t*)(ws + WS_GS), (const bf16_t*)(ws + WS_US), (bf16_t*)(ws + WS_A2), cw, cb);
            for (int item = bx * NTHR + tid; item < DB * (DFF / 8); item += G * NTHR) act_sample_item(item, (const bf16_t*)(ws + WS_SG), (bf16_t*)(ws + WS_A2) + (size_t)RP * DFF, cw, cb, hist);
        }
        GRID_SYNC();

        { LAUNDER_L pg8::SchedStd S; S.init((const bf16_t*)(ws + WS_A2), DFF, WL + WL_DN, DFF, R, DM, G, bx);
          pg8::EpiRes E{(l + 1 < DEPTH) ? nullptr : outp + O_Y, (bf16_t*)(ws + WS_XB), (l + 1 < DEPTH) ? (acc_t*)(ws + WS_SSQ) + (size_t)((l + 1) * 3) * R : nullptr}; pg8::gemm_phase(lds, tid, DFF, DFF, DFF, S, E); }
        { LAUNDER_L
          if (l + 1 < DEPTH) { const bf16_t* wn = (const bf16_t*)(ws + WS_W) + (size_t)(l + 1) * WL_STRIDE;
            pg8::SchedStd S2; S2.init((const bf16_t*)(ws + WS_MB), DM, wn + WL_K, DM, MEMR, 2 * DM, G - 4, bx - 4);
            pg8::EpiKV E2{(bf16_t*)(ws + WS_MK), (const float*)(ws + WS_SSQM), outp + O_MVP + (size_t)(l + 1) * MEMR * DM, (bf16_t*)(ws + WS_MVT)}; pg8::gemm_phase(lds, tid, DM, DM, DM, S2, E2); } }
        GRID_SYNC();
    }
}

extern "C" void kernel_launch(void* const* d_in, const int* in_sizes, int n_in, void* d_out, int out_size, void* d_ws, size_t ws_size, hipStream_t stream) {
    static int grid = 0;
    if (grid == 0) {
        if (n_in != 34 || (size_t)out_size != O_END || ws_size < WS_END) {
            fprintf(stderr, "kernel_launch: unexpected problem: n_in %d out_size %d (want %zu) ws %zu (need %zu); nothing launched\n", n_in, out_size, (size_t)O_END, ws_size, (size_t)WS_END); grid = -1; return; }
        int dev = 0, cus = 0, per_cu = 0;
        (void)hipGetDevice(&dev); (void)hipDeviceGetAttribute(&cus, hipDeviceAttributeMultiprocessorCount, dev);
        if (hipFuncSetAttribute((const void*)fwd_megakernel, hipFuncAttributeMaxDynamicSharedMemorySize, LDS_BYTES) != hipSuccess) { fprintf(stderr, "kernel_launch: hipFuncSetAttribute failed\n"); }
        if (hipOccupancyMaxActiveBlocksPerMultiprocessor(&per_cu, (const void*)fwd_megakernel, NTHR, LDS_BYTES) != hipSuccess || per_cu < 1) { fprintf(stderr, "kernel_launch: occupancy query says %d\n", per_cu); per_cu = 1; }
        (void)hipGetLastError();
        grid = cus * 1;
        if (grid <= 0) grid = 256;
    }
    if (grid < 0) return;
    Params p{};
    for (int i = 0; i < 34; ++i) p.in[i] = (const float*)d_in[i];
    p.out = (float*)d_out; p.ws = (unsigned char*)d_ws;
    void* args[] = {&p};
    hipError_t e = hipLaunchCooperativeKernel((const void*)fwd_megakernel, dim3(grid), dim3(NTHR), args, LDS_BYTES, stream);
    if (e != hipSuccess) fprintf(stderr, "kernel_launch: cooperative launch failed: %s (grid %d)\n", hipGetErrorString(e), grid);
}
```

```cpp
#include <hip/hip_runtime.h>
#include <hip/hip_cooperative_groups.h>
#include <cstdio>
#include <cstdint>
namespace cg = cooperative_groups;

#define LAS __attribute__((address_space(3)))
#define DI __device__ __forceinline__
typedef unsigned short bf16_t;
typedef short bf16x8 __attribute__((ext_vector_type(8)));
typedef float f32x4 __attribute__((ext_vector_type(4)));
typedef float f32x2 __attribute__((ext_vector_type(2)));
typedef float f32x16 __attribute__((ext_vector_type(16)));
typedef unsigned u32x4 __attribute__((ext_vector_type(4)));
typedef unsigned u32x2 __attribute__((ext_vector_type(2)));
typedef __bf16 bf16x2_t __attribute__((ext_vector_type(2)));

constexpr int DM = 1024, SEQ = 2048, NBATCH = 32, DEPTH = 4, RP = NBATCH * SEQ, DB = 8, DSEQ = 32, RS = DB * DSEQ, R = RP + RS;
constexpr int PAST = 1024, INC = 2560, DFF = 2816, UPC = 2 * DFF, MEMR = NBATCH * 256, NWAVES = 8, NTHR = 512;
constexpr float EPS = 1e-6f, LOG2E = 1.4426950408889634f;
constexpr float QSCALE = 0.125f * LOG2E;
constexpr float XSCALE = 0.0625f * LOG2E;

constexpr size_t O_Y = 0;
constexpr size_t O_DKP = (size_t)R * DM;
constexpr size_t O_DVP = O_DKP + (size_t)DEPTH * RP * 512;
constexpr size_t O_MKP = O_DVP + (size_t)DEPTH * RP * 512;
constexpr size_t O_MVP = O_MKP + (size_t)DEPTH * MEMR * DM;
constexpr size_t O_FCP = O_MVP + (size_t)DEPTH * MEMR * DM;
constexpr size_t O_DKS = O_FCP + (size_t)DEPTH * NBATCH * 2 * DFF;
constexpr size_t O_DVS = O_DKS + (size_t)DEPTH * RS * 512;
constexpr size_t O_GVS = O_DVS + (size_t)DEPTH * RS * 512;
constexpr size_t O_FCS = O_GVS + (size_t)DEPTH * RS * 512;
constexpr size_t O_END = O_FCS + (size_t)DEPTH * DB * 2 * DFF;

constexpr size_t MiB = 1u << 20;
constexpr size_t WS_SSQ = 0;
constexpr size_t WS_SSQM = 6 * MiB + MiB / 2;
constexpr size_t WS_BAR = 6 * MiB + MiB / 2 + 65536;
constexpr size_t WS_SSQQ = 6 * MiB + 3 * MiB / 4;
constexpr size_t WS_LSUM = 9 * MiB;
constexpr size_t WS_W = 11 * MiB;
constexpr size_t WS_XB = 137 * MiB;
constexpr size_t WS_MB = 266 * MiB;
constexpr size_t WS_MK = 282 * MiB;
constexpr size_t WS_MVT = 298 * MiB;
constexpr size_t WS_A = 314 * MiB;
constexpr size_t WS_Z = WS_A;
constexpr size_t WS_P = WS_A;
constexpr size_t WS_H = WS_A + 322 * MiB;
constexpr size_t WS_Q = WS_A + 451 * MiB;
constexpr size_t WS_VT = WS_Q;
constexpr size_t WS_A2 = WS_A;
constexpr size_t WS_GS = WS_A + 451 * MiB;
constexpr size_t WS_US = WS_A + 474 * MiB;
constexpr size_t WS_SG = WS_A + 486 * MiB;
constexpr size_t WS_END = WS_A + 580 * MiB;
static_assert((size_t)R * INC * 2 <= 322 * MiB && (size_t)R * DM * 2 <= 129 * MiB && (size_t)R * DFF * 2 <= 451 * MiB && (size_t)(RP / 64) * 4 * DFF * 2 <= 23 * MiB && (size_t)(RP / 64) * 2 * DFF * 2 <= 12 * MiB && (size_t)RS * UPC * 2 <= 3 * MiB, "region A map");
static_assert((size_t)DEPTH * 3 * R * 8 <= WS_SSQM && WS_SSQM + MEMR * 4 <= WS_SSQQ && WS_SSQQ + (size_t)R * 32 <= WS_LSUM && WS_LSUM + (size_t)RP * 32 <= WS_W, "ctl map");
constexpr size_t WL_IN = 0, WL_OUT = WL_IN + (size_t)INC * DM, WL_Q = WL_OUT + (size_t)DM * DM, WL_K = WL_Q + (size_t)DM * DM, WL_V = WL_K + (size_t)DM * DM,
                 WL_O = WL_V + (size_t)DM * DM, WL_UP = WL_O + (size_t)DM * DM, WL_DN = WL_UP + (size_t)UPC * DM, WL_STRIDE = WL_DN + (size_t)DM * DFF;
static_assert(WS_W + DEPTH * WL_STRIDE * 2 <= WS_XB, "weights map");

constexpr int LDS_BYTES = 147456;

struct Params {
    const float* in[34];
    float* out;
    unsigned char* ws;
};
typedef const Params __attribute__((address_space(4)))* KParams;
DI KParams kparams() { KParams kp = (KParams)__builtin_amdgcn_kernarg_segment_ptr(); asm volatile("" : "+s"(kp)); return kp; }

DI unsigned pk2(float lo, float hi) { f32x2 v = {lo, hi}; bf16x2_t b = __builtin_convertvector(v, bf16x2_t); return __builtin_bit_cast(unsigned, b); }
DI float bflo(unsigned w) { return __uint_as_float(w << 16); }
DI float bfhi(unsigned w) { return __uint_as_float(w & 0xffff0000u); }
DI float wave_sum(float v) {
#pragma unroll
    for (int o = 1; o < 64; o <<= 1) v += __shfl_xor(v, o);
    return v;
}
DI float wave_max(float v) {
#pragma unroll
    for (int o = 1; o < 64; o <<= 1) v = fmaxf(v, __shfl_xor(v, o));
    return v;
}
DI float gelu_t(float x) {
    const float u = 0.7978845608028654f * (x + 0.044715f * x * x * x);
    const float e = __builtin_amdgcn_exp2f(-2.f * LOG2E * u);
    return x * __builtin_amdgcn_rcpf(1.f + e);
}
DI float silu_f(float x) { return x * __builtin_amdgcn_rcpf(1.f + __builtin_amdgcn_exp2f(-LOG2E * x)); }
DI float rstd_of(float ssq, float inv_n) { return 1.0f / sqrtf(ssq * inv_n + EPS); }
typedef unsigned long long acc_t;
constexpr float SSQ_SCALE = 1048576.0f, LS_SCALE = 16777216.0f;
DI void acc_add(acc_t* p, float v, float scale) { atomicAdd(p, (acc_t)(v * scale)); }
DI float acc_get(const acc_t* p, float inv_scale) { return (float)(*p) * inv_scale; }
DI float acc_get_i(const acc_t* base, unsigned idx, float inv_scale) { return (float)(*(const acc_t*)((const char*)base + idx * 8u)) * inv_scale; }
DI void unpack8(const u32x4 w, float (&v)[8]) {
    v[0] = bflo(w.x); v[1] = bfhi(w.x); v[2] = bflo(w.y); v[3] = bfhi(w.y); v[4] = bflo(w.z); v[5] = bfhi(w.z); v[6] = bflo(w.w); v[7] = bfhi(w.w);
}
DI u32x4 pack8(const float (&v)[8]) { u32x4 w; w.x = pk2(v[0], v[1]); w.y = pk2(v[2], v[3]); w.z = pk2(v[4], v[5]); w.w = pk2(v[6], v[7]); return w; }
template <class T> DI T* boff(T* base, unsigned byte_off) { return (T*)((char*)base + byte_off); }
DI float lam_init_of(int l) { return l == 0 ? 0.2f : l == 1 ? 0.35550906759096934f : l == 2 ? 0.4707130183435842f : 0.5560582041556406f; }
namespace pg8 {
constexpr int BM = 256, BK = 64, HALF = 128, HTB = HALF * BK * 2, STAGE_BYTES = 8 * HTB, NXCD = 8, WGM = 8;
DI int lds_byte(int r, int c) { const int st = (r >> 4) * 2 + (c >> 5), rr = r & 15, cc = c & 31, ob = rr * 64 + cc * 2; return st * 1024 + (ob ^ (((ob >> 9) & 1) << 5)); }
DI void stage_rc(int b, int& Rr, int& C) { const int st = b / 1024, sb = b % 1024, swz = sb ^ (((sb >> 9) & 1) << 5); Rr = (st >> 1) * 16 + swz / 64; C = (st & 1) * 32 + (swz % 64) / 2; }
DI int perm32(int rho) { const int n = rho >> 4, i = rho & 15; return 8 * (i >> 2) + 4 * n + (i & 3); }
struct Unit { int pm, pn; };

struct SchedStd {
    int nM, nN, nwg, G, c; const char* A; const char* B; size_t tA, tB;
    DI void init(const bf16_t* A_, int lda, const bf16_t* B_, int ldb, int M, int N, int G_, int c_) { nM = M / BM; nN = N / BM; nwg = nM * nN; G = G_; c = c_; A = (const char*)A_; B = (const char*)B_; tA = (size_t)BM * lda * 2; tB = (size_t)BM * ldb * 2; }
    DI bool next(int i, Unit& u) const {
        const long L = (long)i * G + c; if (c < 0 || L >= nwg) return false;
        int wgid = (int)L; { const int q = nwg / NXCD, r = nwg % NXCD, xcd = wgid % NXCD, off = wgid / NXCD; wgid = (xcd < r ? xcd * (q + 1) : r * (q + 1) + (xcd - r) * q) + off; }
        const int nig = WGM * nN, gid = wgid / nig, fm = gid * WGM, gsz = (nM - fm) < WGM ? (nM - fm) : WGM;
        u.pm = fm + ((wgid % nig) % gsz); u.pn = (wgid % nig) / gsz; return true;
    }
    DI const char* a_base(const Unit& u) const { return A + (size_t)u.pm * tA; }
    DI const char* b_base(const Unit& u) const { return B + (size_t)u.pn * tB; }
};
struct SchedX {
    int G, c; const char* A; const char* B; size_t bB, hB;
    DI bool next(int i, Unit& u) const { const int L = i * G + c; if (L >= (RP / BM) * 4) return false; u.pm = L >> 2; u.pn = L & 3; return true; }
    DI const char* a_base(const Unit& u) const { return A + ((size_t)u.pm * BM * DM + (size_t)u.pn * 256) * 2; }
    DI const char* b_base(const Unit& u) const { return B + (size_t)(u.pm >> 3) * bB + (size_t)u.pn * hB; }
};

template <class Epi, class Sched>
DI void gemm_phase(LAS unsigned char* lds, const int tid, const int K, const int lda, const int ldb, const Sched& S, const Epi& E) {
    const int wid = __builtin_amdgcn_readfirstlane(tid >> 6), lane = tid & 63, wr = wid >> 2, wc = wid & 3, fr = lane & 15, fq = lane >> 4;
    const int nt = K / BK;
    unsigned voffA[2], voffB[2];
#pragma unroll
    for (int i = 0; i < 2; ++i) { int Rr, C; stage_rc(tid * 16 + i * 8192, Rr, C); const int Rb = Epi::PERM ? ((Rr & ~31) + perm32(Rr & 31)) : Rr;
        voffA[i] = (unsigned)(Rr * lda + C) * 2u; voffB[i] = (unsigned)(Rb * ldb + C) * 2u; }
    const size_t kstep = (size_t)(BK * 2);
    const size_t hA = (size_t)HALF * lda * 2, hB = (size_t)HALF * ldb * 2;
    const unsigned ldsw = (unsigned)wid * 1024u;
    const int aoff = lds_byte(wr * 64 + fr, fq * 8), boff = lds_byte(wc * 32 + fr, fq * 8);
#define PG8_SA(b, h) (((b) * 2 + (h)) * HTB)
#define PG8_SB(b, h) ((4 + (b) * 2 + (h)) * HTB)
#define PG8_STAGE(bufoff, gbase, voff) do { _Pragma("unroll") for (int _i = 0; _i < 2; ++_i) \
        __builtin_amdgcn_global_load_lds((const unsigned*)((const char*)(gbase) + (voff)[_i]), (LAS unsigned*)(lds + (bufoff) + ldsw + _i * 8192), 16, 0, 0); } while (0)
#define PG8_LDA(dst, b, h) do { _Pragma("unroll") for (int m = 0; m < 4; ++m) _Pragma("unroll") for (int k = 0; k < 2; ++k) dst[m][k] = *(const LAS bf16x8*)(lds + PG8_SA(b, h) + aoff + m * 2048 + k * 1024); } while (0)
#define PG8_LDB(dst, b, h) do { _Pragma("unroll") for (int n = 0; n < 2; ++n) _Pragma("unroll") for (int k = 0; k < 2; ++k) dst[n][k] = *(const LAS bf16x8*)(lds + PG8_SB(b, h) + boff + n * 2048 + k * 1024); } while (0)
#define PG8_MMA(ai, bj, At, Bt) do { __builtin_amdgcn_s_setprio(1); _Pragma("unroll") for (int m = 0; m < 4; ++m) _Pragma("unroll") for (int n = 0; n < 2; ++n) _Pragma("unroll") for (int k = 0; k < 2; ++k) \
        acc[ai][bj][m][n] = __builtin_amdgcn_mfma_f32_16x16x32_bf16(Bt[n][k], At[m][k], acc[ai][bj][m][n], 0, 0, 0); __builtin_amdgcn_s_setprio(0); } while (0)
#define PG8_WAIT_V(n) asm volatile("s_waitcnt vmcnt(" #n ")" ::: "memory")
#define PG8_WAIT_L(n) asm volatile("s_waitcnt lgkmcnt(" #n ")" ::: "memory")
#define PG8_BAR __builtin_amdgcn_s_barrier()
#define PG8_SCHED __builtin_amdgcn_sched_barrier(0)
    Unit cur, nxt; int ui = 0;
    if (!S.next(0, cur)) return;
    f32x4 acc[2][2][4][2];
#pragma unroll
    for (int a = 0; a < 2; ++a)
#pragma unroll
        for (int b = 0; b < 2; ++b)
#pragma unroll
            for (int m = 0; m < 4; ++m)
#pragma unroll
                for (int n = 0; n < 2; ++n) acc[a][b][m][n] = (f32x4){0.f, 0.f, 0.f, 0.f};
    bf16x8 At[4][2], B0[2][2], B1[2][2];
    const char* cA = S.a_base(cur); const char* cB = S.b_base(cur);
    PG8_STAGE(PG8_SB(0, 0), cB, voffB); PG8_STAGE(PG8_SB(0, 1), cB + hB, voffB); PG8_STAGE(PG8_SA(0, 0), cA, voffA); PG8_STAGE(PG8_SA(0, 1), cA + hA, voffA);
    if (wr == 1) PG8_BAR;
    PG8_WAIT_V(2); PG8_BAR;
    PG8_STAGE(PG8_SB(1, 0), cB + kstep, voffB); PG8_STAGE(PG8_SA(1, 0), cA + kstep, voffA); PG8_STAGE(PG8_SB(1, 1), cB + hB + kstep, voffB);
    PG8_WAIT_V(6); PG8_BAR;
    for (;;) {
        const bool has_next = S.next(ui + 1, nxt);
        const char* nA = has_next ? S.a_base(nxt) : cA; const char* nB = has_next ? S.b_base(nxt) : cB;
#pragma unroll 1
        for (int t = 0; t < nt; t += 2) {
            const bool last = (t == nt - 2);
            const char* a1 = cA + (size_t)(t + 1) * kstep;
            const char* a2 = last ? nA : cA + (size_t)(t + 2) * kstep; const char* b2 = last ? nB : cB + (size_t)(t + 2) * kstep;
            const char* a3 = a2 + kstep; const char* b3 = b2 + kstep;
            PG8_LDB(B0, 0, 0); PG8_LDB(B1, 0, 1); PG8_SCHED; PG8_LDA(At, 0, 0); PG8_STAGE(PG8_SA(1, 1), a1 + hA, voffA);
            PG8_WAIT_V(8); PG8_WAIT_L(0); PG8_BAR; PG8_MMA(0, 0, At, B0); PG8_MMA(0, 1, At, B1); PG8_BAR; PG8_SCHED;
            PG8_LDA(At, 0, 1); PG8_STAGE(PG8_SB(0, 0), b2, voffB); PG8_STAGE(PG8_SB(0, 1), b2 + hB, voffB); PG8_STAGE(PG8_SA(0, 0), a2, voffA);
            PG8_WAIT_V(8); PG8_WAIT_L(0); PG8_BAR; PG8_MMA(1, 0, At, B0); PG8_MMA(1, 1, At, B1); PG8_BAR; PG8_SCHED;
            PG8_LDB(B0, 1, 0); PG8_LDB(B1, 1, 1); PG8_SCHED; PG8_LDA(At, 1, 0); PG8_STAGE(PG8_SA(0, 1), a2 + hA, voffA);
            PG8_WAIT_V(8); PG8_WAIT_L(0); PG8_BAR; PG8_MMA(0, 0, At, B0); PG8_MMA(0, 1, At, B1); PG8_BAR; PG8_SCHED;
            PG8_LDA(At, 1, 1); PG8_STAGE(PG8_SB(1, 0), b3, voffB); PG8_STAGE(PG8_SB(1, 1), b3 + hB, voffB); PG8_STAGE(PG8_SA(1, 0), a3, voffA);
            PG8_WAIT_V(8); PG8_WAIT_L(0); PG8_BAR; PG8_MMA(1, 0, At, B0); PG8_MMA(1, 1, At, B1); PG8_BAR; PG8_SCHED;
        }
        if (wr == 0) PG8_BAR;
        E(acc, cur, wr, wc, fr, fq);
        if (!has_next) break;
#pragma unroll
        for (int a = 0; a < 2; ++a)
#pragma unroll
            for (int b = 0; b < 2; ++b)
#pragma unroll
                for (int m = 0; m < 4; ++m)
#pragma unroll
                    for (int n = 0; n < 2; ++n) acc[a][b][m][n] = (f32x4){0.f, 0.f, 0.f, 0.f};
        cur = nxt; cA = nA; cB = nB; ++ui;
        if (wr == 1) PG8_BAR;
    }
    PG8_WAIT_V(0);
    PG8_BAR;
#undef PG8_SA
#undef PG8_SB
#undef PG8_STAGE
#undef PG8_LDA
#undef PG8_LDB
#undef PG8_MMA
#undef PG8_WAIT_V
#undef PG8_WAIT_L
#undef PG8_BAR
#undef PG8_SCHED
}

#define EPI_ROWS_BEGIN _Pragma("unroll") for (int ai = 0; ai < 2; ++ai) _Pragma("unroll") for (int m = 0; m < 4; ++m) { const int row = u.pm * BM + ai * HALF + wr * 64 + m * 16 + fr;
#define EPI_ROWS_END }


DI void store_pair_transposed(bf16_t* Tcol0, int pitch, int r, int fr, unsigned w01, unsigned w23, unsigned w45, unsigned w67) {
    const bool odd = fr & 1;
    const unsigned s0 = odd ? w01 : w45, s1 = odd ? w23 : w67;
    const unsigned r0 = __shfl_xor(s0, 1), r1 = __shfl_xor(s1, 1);
    const unsigned X0 = odd ? r0 : w01, X1 = odd ? r1 : w23, Y0 = odd ? w45 : r0, Y1 = odd ? w67 : r1;
    bf16_t* base = Tcol0 + (size_t)(odd ? 4 : 0) * pitch + (r & ~1);
    *(unsigned*)(base) = (X0 & 0xffffu) | (Y0 << 16);
    *(unsigned*)(base + pitch) = (X0 >> 16) | (Y0 & 0xffff0000u);
    *(unsigned*)(base + 2 * (size_t)pitch) = (X1 & 0xffffu) | (Y1 << 16);
    *(unsigned*)(base + 3 * (size_t)pitch) = (X1 >> 16) | (Y1 & 0xffff0000u);
}
struct EpiIn {
    static constexpr bool PERM = true;
    bf16_t* Z; const acc_t* ssq; float* dvp; float* dvs; bf16_t* VT; LAS float* xl; const float* qg; const float* kg; float* dkp; float* dks; const float* rope;
    DI void operator()(const f32x4 (&acc)[2][2][4][2], const Unit& u, int wr, int wc, int fr, int fq) const {
        const int colb = u.pn * BM + wc * 32 + 8 * fq;
        if (u.pn < 4) {
            int fr_ = fr, fq_ = fq, wc_ = wc, wr_ = wr; asm volatile("" : "+v"(fr_), "+v"(fq_), "+s"(wc_), "+s"(wr_));
            const int wv = wr_ * 4 + wc_;
            _Pragma("unroll") for (int ai = 0; ai < 2; ++ai) _Pragma("unroll") for (int m = 0; m < 4; ++m) { const int row = u.pm * BM + ai * HALF + wr_ * 64 + m * 16 + fr_;
                const float rs = rstd_of(acc_get_i(ssq, (unsigned)row, 1.0f / SSQ_SCALE), 1.0f / DM);
#pragma unroll
                for (int bj = 0; bj < 2; ++bj) { const f32x4 v0 = acc[ai][bj][m][0] * rs, v1 = acc[ai][bj][m][1] * rs;
                    float ss = (v0[0] * v0[0] + v0[1] * v0[1]) + (v0[2] * v0[2] + v0[3] * v0[3]) + (v1[0] * v1[0] + v1[1] * v1[1]) + (v1[2] * v1[2] + v1[3] * v1[3]);
                    ss += __shfl_xor(ss, 16); ss += __shfl_xor(ss, 32);
                    if (fq_ == 0) xl[(wv * 2 + bj) * 128 + ai * 64 + m * 16 + fr_] = ss; }
            }
            asm volatile("s_waitcnt lgkmcnt(0)" ::: "memory"); __builtin_amdgcn_s_barrier(); asm volatile("" ::: "memory");
            int pnv = u.pn; asm volatile("" : "+s"(pnv));
            const bool isq = pnv < 2, ropew = (wc_ & 1) == 0;
            const float* gp = (isq ? qg : kg) + (wc_ & 1) * 32 + 8 * fq_;
            const f32x4 g0 = *(const f32x4*)gp, g1 = *(const f32x4*)(gp + 4);
            _Pragma("unroll") for (int ai = 0; ai < 2; ++ai) _Pragma("unroll") for (int m = 0; m < 4; ++m) { const int row = u.pm * BM + ai * HALF + wr_ * 64 + m * 16 + fr_;
                const float rs = rstd_of(acc_get_i(ssq, (unsigned)row, 1.0f / SSQ_SCALE), 1.0f / DM);
                const int pos = row < RP ? (row & (SEQ - 1)) : PAST + ((row - RP) & (DSEQ - 1));
                f32x4 c0 = {1.f, 1.f, 1.f, 1.f}, c1 = c0, s0 = {0.f, 0.f, 0.f, 0.f}, s1 = s0;
                if (ropew) { const f32x4* tp = (const f32x4*)(rope + pos * 16); c0 = tp[0]; c1 = tp[1]; s0 = tp[2]; s1 = tp[3]; }
#pragma unroll
                for (int bj = 0; bj < 2; ++bj) { const int col = (u.pn * BM + wc_ * 32 + 8 * fq_) + bj * HALF;
                    const int ri = bj * 128 + ai * 64 + m * 16 + fr_;
                    const float tot = xl[(wv & ~1) * 256 + ri] + xl[(wv | 1) * 256 + ri];
                    const float rn = rs * rstd_of(tot, 1.0f / 64.f);
                    float x[8];
#pragma unroll
                    for (int j = 0; j < 4; ++j) { x[j] = acc[ai][bj][m][0][j] * rn * g0[j]; x[4 + j] = acc[ai][bj][m][1][j] * rn * g1[j]; }
                    if (ropew) {
#pragma unroll
                        for (int j = 0; j < 8; ++j) { const float other = __shfl_xor(x[j], 16);
                            const float sn = j < 4 ? s0[j & 3] : s1[j & 3], cs = j < 4 ? c0[j & 3] : c1[j & 3];
                            const float r0 = x[j] * cs - other * sn, r1 = x[j] * cs + other * sn;
                            x[j] = fq_ == 0 ? r0 : (fq_ == 1 ? r1 : x[j]); } }
                    if (!isq) { float* dst = (row < RP ? dkp + (size_t)row * 512 : dks + (size_t)(row - RP) * 512) + (col - 512);
                        *(f32x4*)dst = (f32x4){x[0], x[1], x[2], x[3]}; *(f32x4*)(dst + 4) = (f32x4){x[4], x[5], x[6], x[7]}; }
                    else {
#pragma unroll
                        for (int j = 0; j < 8; ++j) x[j] *= QSCALE; }
                    u32x4 w; w.x = pk2(x[0], x[1]); w.y = pk2(x[2], x[3]); w.z = pk2(x[4], x[5]); w.w = pk2(x[6], x[7]);
                    *(u32x4*)(Z + (size_t)row * INC + col) = w; }
                asm volatile("" ::: "memory");
            }
            return;
        }
        EPI_ROWS_BEGIN
            const float rs = rstd_of(acc_get(ssq + row, 1.0f / SSQ_SCALE), 1.0f / DM);
#pragma unroll
            for (int bj = 0; bj < 2; ++bj) { const int col = colb + bj * HALF; f32x4 v0 = acc[ai][bj][m][0] * rs, v1 = acc[ai][bj][m][1] * rs;
                if (u.pn == 4 || u.pn == 5) { float* dst = (row < RP ? dvp + (size_t)row * 512 : dvs + (size_t)(row - RP) * 512) + (col - 1024); *(f32x4*)dst = v0; *(f32x4*)(dst + 4) = v1;
                    if (u.pm < RP / BM) store_pair_transposed(VT + ((size_t)(row >> 11) * 512 + (col - 1024)) * SEQ, SEQ, row & (SEQ - 1), fr, pk2(v0[0], v0[1]), pk2(v0[2], v0[3]), pk2(v1[0], v1[1]), pk2(v1[2], v1[3])); }
                else {
#pragma unroll
                    for (int j = 0; j < 4; ++j) { v0[j] = gelu_t(v0[j]); v1[j] = gelu_t(v1[j]); }
                    u32x4 w; w.x = pk2(v0[0], v0[1]); w.y = pk2(v0[2], v0[3]); w.z = pk2(v1[0], v1[1]); w.w = pk2(v1[2], v1[3]);
                    *(u32x4*)(Z + (size_t)row * INC + col) = w; } }
        EPI_ROWS_END
    }
};

struct EpiKV {
    static constexpr bool PERM = true;
    bf16_t* MK; const float* ssq; float* mvp; bf16_t* MVT;
    DI void operator()(const f32x4 (&acc)[2][2][4][2], const Unit& u, int wr, int wc, int fr, int fq) const {
        const int colb = (u.pn & 3) * BM + wc * 32 + 8 * fq;
        EPI_ROWS_BEGIN
            const float rs = rstd_of(ssq[row], 1.0f / DM);
#pragma unroll
            for (int bj = 0; bj < 2; ++bj) { const int col = colb + bj * HALF; const f32x4 v0 = acc[ai][bj][m][0] * rs, v1 = acc[ai][bj][m][1] * rs;
                if (u.pn >= 4) { float* dst = mvp + (size_t)row * DM + col; *(f32x4*)dst = v0; *(f32x4*)(dst + 4) = v1;
                    store_pair_transposed(MVT + ((size_t)(row >> 8) * DM + col) * 256, 256, row & 255, fr, pk2(v0[0], v0[1]), pk2(v0[2], v0[3]), pk2(v1[0], v1[1]), pk2(v1[2], v1[3])); }
                else { u32x4 w; w.x = pk2(v0[0], v0[1]); w.y = pk2(v0[2], v0[3]); w.z = pk2(v1[0], v1[1]); w.w = pk2(v1[2], v1[3]); *(u32x4*)(MK + (size_t)row * DM + col) = w; } }
        EPI_ROWS_END
    }
};
struct EpiRes {
    static constexpr bool PERM = true;
    float* Y; bf16_t* XB; acc_t* ssq_next;
    DI void operator()(const f32x4 (&acc)[2][2][4][2], const Unit& u, int wr, int wc, int fr, int fq) const {
        const int colb = u.pn * BM + wc * 32 + 8 * fq;
        EPI_ROWS_BEGIN
            float ss = 0.f;
#pragma unroll
            for (int bj = 0; bj < 2; ++bj) { const int col = colb + bj * HALF; bf16_t* xp = XB + (size_t)row * DM + col;
                float xv[8]; unpack8(*(const u32x4*)xp, xv);
                const f32x4 x0 = (f32x4){xv[0], xv[1], xv[2], xv[3]} + acc[ai][bj][m][0], x1 = (f32x4){xv[4], xv[5], xv[6], xv[7]} + acc[ai][bj][m][1];
                if (Y != nullptr) { float* yp = Y + (size_t)row * DM + col; *(f32x4*)yp = x0; *(f32x4*)(yp + 4) = x1; }
                u32x4 w; w.x = pk2(x0[0], x0[1]); w.y = pk2(x0[2], x0[3]); w.z = pk2(x1[0], x1[1]); w.w = pk2(x1[2], x1[3]); *(u32x4*)xp = w;
                ss += (x0[0] * x0[0] + x0[1] * x0[1]) + (x0[2] * x0[2] + x0[3] * x0[3]) + (x1[0] * x1[0] + x1[1] * x1[1]) + (x1[2] * x1[2] + x1[3] * x1[3]); }
            ss += __shfl_xor(ss, 16); ss += __shfl_xor(ss, 32);
            if (ssq_next != nullptr && fq == 0) acc_add(ssq_next + row, ss, SSQ_SCALE);
        EPI_ROWS_END
    }
};

struct EpiQ {
    static constexpr bool PERM = true;
    bf16_t* Q; const acc_t* ssq; acc_t* ssqq;
    DI void operator()(const f32x4 (&acc)[2][2][4][2], const Unit& u, int wr, int wc, int fr, int fq) const {
        const int colb = u.pn * BM + wc * 32 + 8 * fq;
        EPI_ROWS_BEGIN
            const float rs = rstd_of(acc_get(ssq + row, 1.0f / SSQ_SCALE), 1.0f / DM); float ss = 0.f;
#pragma unroll
            for (int bj = 0; bj < 2; ++bj) { const int col = colb + bj * HALF; const f32x4 v0 = acc[ai][bj][m][0] * rs, v1 = acc[ai][bj][m][1] * rs;
                u32x4 w; w.x = pk2(v0[0], v0[1]); w.y = pk2(v0[2], v0[3]); w.z = pk2(v1[0], v1[1]); w.w = pk2(v1[2], v1[3]); *(u32x4*)(Q + (size_t)row * DM + col) = w;
                ss += (v0[0] * v0[0] + v0[1] * v0[1]) + (v0[2] * v0[2] + v0[3] * v0[3]) + (v1[0] * v1[0] + v1[1] * v1[1]) + (v1[2] * v1[2] + v1[3] * v1[3]); }
            ss += __shfl_xor(ss, 16); ss += __shfl_xor(ss, 32);
            if (fq == 0) acc_add(ssqq + (size_t)row * 4 + u.pn, ss, SSQ_SCALE);
        EPI_ROWS_END
    }
};
struct EpiS {
    static constexpr bool PERM = true;
    bf16_t* P; const acc_t* ssqq; acc_t* lsum;
    DI void operator()(const f32x4 (&acc)[2][2][4][2], const Unit& u, int wr, int wc, int fr, int fq) const {
        const int colb = u.pn * BM + wc * 32 + 8 * fq;
        EPI_ROWS_BEGIN
            const float rs = rstd_of(acc_get(ssqq + (size_t)row * 4 + u.pn, 1.0f / SSQ_SCALE), 1.0f / 256.f) * XSCALE; float ss = 0.f;
#pragma unroll
            for (int bj = 0; bj < 2; ++bj) { const int col = colb + bj * HALF; f32x4 v0 = acc[ai][bj][m][0] * rs, v1 = acc[ai][bj][m][1] * rs;
#pragma unroll
                for (int j = 0; j < 4; ++j) { v0[j] = __builtin_amdgcn_exp2f(v0[j]); v1[j] = __builtin_amdgcn_exp2f(v1[j]); }
                u32x4 w; w.x = pk2(v0[0], v0[1]); w.y = pk2(v0[2], v0[3]); w.z = pk2(v1[0], v1[1]); w.w = pk2(v1[2], v1[3]); *(u32x4*)(P + (size_t)row * DM + col) = w;
                ss += (v0[0] + v0[1]) + (v0[2] + v0[3]) + (v1[0] + v1[1]) + (v1[2] + v1[3]); }
            ss += __shfl_xor(ss, 16); ss += __shfl_xor(ss, 32);
            if (fq == 0) acc_add(lsum + (size_t)row * 4 + u.pn, ss, LS_SCALE);
        EPI_ROWS_END
    }
};
struct EpiPV {
    static constexpr bool PERM = true;
    bf16_t* H; const acc_t* lsum;
    DI void operator()(const f32x4 (&acc)[2][2][4][2], const Unit& u, int wr, int wc, int fr, int fq) const {
        const int colb = u.pn * BM + wc * 32 + 8 * fq;
        EPI_ROWS_BEGIN
            const float rs = 1.0f / acc_get(lsum + (size_t)row * 4 + u.pn, 1.0f / LS_SCALE);
#pragma unroll
            for (int bj = 0; bj < 2; ++bj) { const int col = colb + bj * HALF; const f32x4 v0 = acc[ai][bj][m][0] * rs, v1 = acc[ai][bj][m][1] * rs;
                u32x4 w; w.x = pk2(v0[0], v0[1]); w.y = pk2(v0[2], v0[3]); w.z = pk2(v1[0], v1[1]); w.w = pk2(v1[2], v1[3]); *(u32x4*)(H + (size_t)row * DM + col) = w; }
        EPI_ROWS_END
    }
};
struct EpiUpAct {
    static constexpr bool PERM = true;
    bf16_t* A2; const acc_t* ssq; bf16_t* GS; bf16_t* US; bf16_t* SG; const float* cw; const float* cb; float* fcp; float* fcs;
    DI void operator()(const f32x4 (&acc)[2][2][4][2], const Unit& u, int wr, int wc, int fr, int fq) const {
        const int c8 = u.pn * HALF + wc * 32 + 8 * fq;
        if (u.pm == RP / BM) {
            Unit uu = u; asm volatile("" : "+s"(uu.pm));
            const Unit& u = uu;
            EPI_ROWS_BEGIN
                const float rs = rstd_of(acc_get(ssq + row, 1.0f / SSQ_SCALE), 1.0f / DM); const int sr = row - RP;
#pragma unroll
                for (int bj = 0; bj < 2; ++bj) { const f32x4 v0 = acc[ai][bj][m][0] * rs, v1 = acc[ai][bj][m][1] * rs;
                    u32x4 w; w.x = pk2(v0[0], v0[1]); w.y = pk2(v0[2], v0[3]); w.z = pk2(v1[0], v1[1]); w.w = pk2(v1[2], v1[3]); *(u32x4*)(SG + (size_t)sr * UPC + bj * DFF + c8) = w;
                    if (bj == 0 && (sr & 31) >= 30) { float* dst = fcs + ((size_t)(sr >> 5) * 2 + ((sr & 31) - 30)) * DFF + c8; *(f32x4*)dst = v0; *(f32x4*)(dst + 4) = v1; } }
            EPI_ROWS_END
            return;
        }
        const int src1 = (fq << 4) | ((fr + 15) & 15), src2 = (fq << 4) | ((fr + 14) & 15);
#pragma unroll
        for (int n = 0; n < 2; ++n) {
            const int c4 = c8 + 4 * n;
            const f32x4 w0 = *(const f32x4*)(cw + c4), w1 = *(const f32x4*)(cw + DFF + c4), w2 = *(const f32x4*)(cw + 2 * DFF + c4), cbv = *(const f32x4*)(cb + c4);
#pragma unroll
            for (int ai = 0; ai < 2; ++ai) {
                f32x4 pg = {0.f, 0.f, 0.f, 0.f};
#pragma unroll
                for (int m = 0; m < 4; ++m) { const int row = u.pm * BM + ai * HALF + wr * 64 + m * 16 + fr;
                    const float rs = rstd_of(acc_get_i(ssq, (unsigned)row, 1.0f / SSQ_SCALE), 1.0f / DM);
                    const f32x4 g = acc[ai][0][m][n] * rs, up = acc[ai][1][m][n] * rs;
                    f32x4 a;
#pragma unroll
                    for (int j = 0; j < 4; ++j) { const float s1 = __shfl(fr == 15 ? pg[j] : g[j], src1), s2 = __shfl(fr >= 14 ? pg[j] : g[j], src2);
                        a[j] = silu_f(cbv[j] + w0[j] * s2 + w1[j] * s1 + w2[j] * g[j]) * up[j]; }
                    u32x2 gw; gw.x = pk2(g[0], g[1]); gw.y = pk2(g[2], g[3]);
                    if (m == 0 && fr < 2) {
                        *boff((u32x2*)GS, (unsigned)(((row >> 6) * 4 + 2 + fr) * DFF + c4) * 2u) = gw;
                        u32x2 uw; uw.x = pk2(up[0], up[1]); uw.y = pk2(up[2], up[3]); *boff((u32x2*)US, (unsigned)(((row >> 6) * 2 + fr) * DFF + c4) * 2u) = uw;
                    } else { u32x2 w; w.x = pk2(a[0], a[1]); w.y = pk2(a[2], a[3]); *boff((u32x2*)A2, (unsigned)(row * DFF + c4) * 2u) = w; }
                    if (m == 3 && fr >= 14) {
                        *boff((u32x2*)GS, (unsigned)(((row >> 6) * 4 + (fr - 14)) * DFF + c4) * 2u) = gw;
                        if ((row & (SEQ - 1)) >= SEQ - 2) *boff((f32x4*)fcp, (unsigned)(((row >> 11) * 2 + ((row & (SEQ - 1)) - (SEQ - 2))) * DFF + c4) * 4u) = g;
                    }
                    pg = g;
                    asm volatile("" ::: "memory");
                }
            }
        }
    }
};

}
template <bool UPMAP = false>
DI void transpose_item(const float* W, int K, int N, bf16_t* WT, const float* gain, LAS float* scr, int item, int lane) {
    const int nblk = N / 32, kb = item / nblk, nb = item % nblk, k0 = 64 * kb, n0 = 32 * nb;
    const int r0 = !UPMAP ? n0 : (n0 < DFF ? ((n0 >> 7) << 8) + (n0 & 127) : (((n0 - DFF) >> 7) << 8) + 128 + ((n0 - DFF) & 127));
#pragma unroll
    for (int i = 0; i < 32; ++i) { const int kk = 2 * i + (lane >> 5); float v = W[(size_t)(k0 + kk) * N + n0 + (lane & 31)]; if (gain) v *= gain[k0 + kk]; scr[kk * 33 + (lane & 31)] = v; }
    asm volatile("s_waitcnt lgkmcnt(0)" ::: "memory");
    const int c = lane & 7;
#pragma unroll
    for (int j = 0; j < 4; ++j) { const int n = (lane >> 3) + 8 * j; const LAS float* s = scr + (8 * c) * 33 + n;
        u32x4 o; o.x = pk2(s[0 * 33], s[1 * 33]); o.y = pk2(s[2 * 33], s[3 * 33]); o.z = pk2(s[4 * 33], s[5 * 33]); o.w = pk2(s[6 * 33], s[7 * 33]);
        *(u32x4*)(WT + (size_t)(r0 + n) * K + k0 + 8 * c) = o; }
    asm volatile("s_waitcnt lgkmcnt(0)" ::: "memory");
}
template <bool UPMAP = false>
DI void convert_matrix(const float* W, int K, int N, bf16_t* WT, const float* gain, LAS float* scr, int gw, int ngw, int lane) {
    const int nitems = (K / 64) * (N / 32);
    for (int it = gw; it < nitems; it += ngw) transpose_item<UPMAP>(W, K, N, WT, gain, scr, it, lane);
}

DI void convert_layer_weights(int l, int part, LAS float* scr, int gw, int ngw, int lane) {
    bf16_t* wl = (bf16_t*)(kparams()->ws + WS_W) + (size_t)l * WL_STRIDE;
    if (part < 0 || part == 0) {
        { KParams p = kparams(); convert_matrix(p->in[9] + (size_t)l * DM * INC, DM, INC, wl + WL_IN, p->in[8] + l * DM, scr, gw, ngw, lane); }
        { KParams p = kparams(); convert_matrix(p->in[20] + (size_t)l * DM * DM, DM, DM, wl + WL_OUT, nullptr, scr, gw, ngw, lane); } }
    if (part < 0 || part == 1) {
        { KParams p = kparams(); convert_matrix(p->in[23] + (size_t)l * DM * DM, DM, DM, wl + WL_Q, p->in[21] + l * DM, scr, gw, ngw, lane); }
        { KParams p = kparams(); convert_matrix(p->in[24] + (size_t)l * DM * DM, DM, DM, wl + WL_K, p->in[22] + l * DM, scr, gw, ngw, lane); }
        { KParams p = kparams(); convert_matrix(p->in[25] + (size_t)l * DM * DM, DM, DM, wl + WL_V, p->in[22] + l * DM, scr, gw, ngw, lane); }
        { KParams p = kparams(); convert_matrix(p->in[26] + (size_t)l * DM * DM, DM, DM, wl + WL_O, nullptr, scr, gw, ngw, lane); } }
    if (part < 0 || part == 2) {
        { KParams p = kparams(); convert_matrix<true>(p->in[30] + (size_t)l * DM * UPC, DM, UPC, wl + WL_UP, p->in[29] + l * DM, scr, gw, ngw, lane); }
        { KParams p = kparams(); convert_matrix(p->in[33] + (size_t)l * DFF * DM, DFF, DM, wl + WL_DN, nullptr, scr, gw, ngw, lane); } }
}
DI void phase_prologue(LAS unsigned char* lds, int gw, int ngw, int wid, int lane) {
    LAS float* scr = (LAS float*)(lds + wid * 16384);
    convert_layer_weights(0, -1, scr, gw, ngw, lane);
    KParams p = kparams();
    acc_t* ssq = (acc_t*)(p->ws + WS_SSQ); bf16_t* XB = (bf16_t*)(p->ws + WS_XB);
    const float* xp = p->in[0]; const float* xs = p->in[1];
    for (int row0 = gw; row0 < R; row0 += 4 * ngw) {
        f32x4 v[4][4];
#pragma unroll
        for (int i = 0; i < 4; ++i) { const int row = row0 + i * ngw; if (row < R) { const float* src = row < RP ? xp + (size_t)row * DM : xs + (size_t)(row - RP) * DM;
#pragma unroll
            for (int j = 0; j < 4; ++j) v[i][j] = *(const f32x4*)(src + 4 * lane + 256 * j); } }
#pragma unroll
        for (int i = 0; i < 4; ++i) { const int row = row0 + i * ngw; if (row < R) { float ss = 0.f;
#pragma unroll
            for (int j = 0; j < 4; ++j) { const f32x4 x = v[i][j]; u32x2 w; w.x = pk2(x[0], x[1]); w.y = pk2(x[2], x[3]); *(u32x2*)(XB + (size_t)row * DM + 4 * lane + 256 * j) = w;
                ss += (x[0] * x[0] + x[1] * x[1]) + (x[2] * x[2] + x[3] * x[3]); }
            ss = wave_sum(ss); if (lane == 0) ssq[row] = (acc_t)(ss * SSQ_SCALE); } }
    }
    float* ssqm = (float*)(p->ws + WS_SSQM); bf16_t* MB = (bf16_t*)(p->ws + WS_MB);
    for (int row = gw; row < MEMR; row += ngw) {
        const float* src = p->in[7] + (size_t)row * DM; float ss = 0.f;
#pragma unroll
        for (int j = 0; j < 4; ++j) { const f32x4 v = *(const f32x4*)(src + 4 * lane + 256 * j);
            u32x2 w; w.x = pk2(v[0], v[1]); w.y = pk2(v[2], v[3]); *(u32x2*)(MB + (size_t)row * DM + 4 * lane + 256 * j) = w;
            ss += (v[0] * v[0] + v[1] * v[1]) + (v[2] * v[2] + v[3] * v[3]); }
        ss = wave_sum(ss); if (lane == 0) ssqm[row] = ss;
    }
    { float* rope = (float*)(p->ws + WS_END);
      const float hi_[8] = {1.5905761719e-01f, 3.0853271484e-02f, 5.9814453125e-03f, 1.1606216431e-03f, 2.2506713867e-04f, 4.3630599976e-05f, 8.4638595581e-06f, 1.6409903765e-06f};
      const float lo_[8] = {9.7325901152e-05f, 1.0491919966e-05f, 3.7404001887e-06f, 4.1998173828e-08f, 1.1940367806e-08f, 1.7352817849e-08f, 4.7125015001e-10f, 4.3588632703e-10f};
      for (int pos = gw * 64 + lane; pos < 2080; pos += ngw * 64) { const float fp = (float)pos;
#pragma unroll
          for (int j = 0; j < 8; ++j) { float t = fp * hi_[j]; t = t - rintf(t); t += fp * lo_[j]; rope[pos * 16 + j] = __builtin_amdgcn_cosf(t); rope[pos * 16 + 8 + j] = __builtin_amdgcn_sinf(t); } } }
    for (int i = R + gw * 64 + lane; i < DEPTH * 3 * R; i += ngw * 64) ssq[i] = 0ull;
}

DI void qk_post_row(bf16_t* Z, int row, const u32x4 w0, const u32x4 w1, const float* qg, const float* kg, float* dkp, float* dks, int lane) {
    bf16_t* ptr = Z + (size_t)row * INC + lane * 16;
    float a[8], b[8]; unpack8(w0, a); unpack8(w1, b);
    float ss = 0.f;
#pragma unroll
    for (int i = 0; i < 8; ++i) ss += a[i] * a[i] + b[i] * b[i];
    ss += __shfl_xor(ss, 1); ss += __shfl_xor(ss, 2);
    const float rs = rstd_of(ss, 1.0f / 64.f);
    const bool isq = lane < 32;
    const float* g = (isq ? qg : kg) + (lane & 3) * 16;
#pragma unroll
    for (int i = 0; i < 8; ++i) { a[i] *= rs * g[i]; b[i] *= rs * g[8 + i]; }
    const int pos = row < RP ? (row & (SEQ - 1)) : PAST + ((row - RP) & (DSEQ - 1));
    if ((lane & 3) == 0) {
        const float fp = (float)pos;
        const float hi[8] = {1.5905761719e-01f, 3.0853271484e-02f, 5.9814453125e-03f, 1.1606216431e-03f, 2.2506713867e-04f, 4.3630599976e-05f, 8.4638595581e-06f, 1.6409903765e-06f};
        const float lo[8] = {9.7325901152e-05f, 1.0491919966e-05f, 3.7404001887e-06f, 4.1998173828e-08f, 1.1940367806e-08f, 1.7352817849e-08f, 4.7125015001e-10f, 4.3588632703e-10f};
#pragma unroll
        for (int i = 0; i < 8; ++i) {
            float t = fp * hi[i]; t = t - rintf(t); t += fp * lo[i];
            const float sn = __builtin_amdgcn_sinf(t), cs = __builtin_amdgcn_cosf(t);
            const float x1 = a[i], x2 = b[i]; a[i] = x1 * cs - x2 * sn; b[i] = x2 * cs + x1 * sn; }
    }
    if (!isq) {
        float* dst = (row < RP ? dkp + (size_t)row * 512 : dks + (size_t)(row - RP) * 512) + (lane - 32) * 16;
        *(f32x4*)dst = (f32x4){a[0], a[1], a[2], a[3]}; *(f32x4*)(dst + 4) = (f32x4){a[4], a[5], a[6], a[7]};
        *(f32x4*)(dst + 8) = (f32x4){b[0], b[1], b[2], b[3]}; *(f32x4*)(dst + 12) = (f32x4){b[4], b[5], b[6], b[7]};
    } else {
#pragma unroll
        for (int i = 0; i < 8; ++i) { a[i] *= QSCALE; b[i] *= QSCALE; }
    }
    *(u32x4*)ptr = pack8(a); *(u32x4*)(ptr + 8) = pack8(b);
}
DI void qk_post_rows(bf16_t* Z, int gw, int ngw, const float* qg, const float* kg, float* dkp, float* dks, int lane) {
    for (int row = gw; row < R; row += 8 * ngw) {
        u32x4 w0[8], w1[8];
#pragma unroll
        for (int i = 0; i < 8; ++i) { const int r = row + i * ngw; if (r < R) { const bf16_t* ptr = Z + (size_t)r * INC + lane * 16; w0[i] = *(const u32x4*)ptr; w1[i] = *(const u32x4*)(ptr + 8); } }
#pragma unroll
        for (int i = 0; i < 8; ++i) { const int r = row + i * ngw; if (r < R) qk_post_row(Z, r, w0[i], w1[i], qg, kg, dkp, dks, lane); }
    }
}
DI void memk_post_row(bf16_t* MK, int row, const u32x4 w0, const u32x4 w1, const float* xkg, const float* xqg, float* mkp, int lane) {
    bf16_t* ptr = MK + (size_t)row * DM + lane * 16;
    float a[8], b[8]; unpack8(w0, a); unpack8(w1, b);
    float ss = 0.f;
#pragma unroll
    for (int i = 0; i < 8; ++i) ss += a[i] * a[i] + b[i] * b[i];
    ss += __shfl_xor(ss, 1); ss += __shfl_xor(ss, 2); ss += __shfl_xor(ss, 4); ss += __shfl_xor(ss, 8);
    const float rs = rstd_of(ss, 1.0f / 256.f);
    const int d0 = (lane & 15) * 16;
#pragma unroll
    for (int i = 0; i < 8; ++i) { a[i] *= rs * xkg[d0 + i]; b[i] *= rs * xkg[d0 + 8 + i]; }
    float* dst = mkp + (size_t)row * DM + lane * 16;
    *(f32x4*)dst = (f32x4){a[0], a[1], a[2], a[3]}; *(f32x4*)(dst + 4) = (f32x4){a[4], a[5], a[6], a[7]};
    *(f32x4*)(dst + 8) = (f32x4){b[0], b[1], b[2], b[3]}; *(f32x4*)(dst + 12) = (f32x4){b[4], b[5], b[6], b[7]};
#pragma unroll
    for (int i = 0; i < 8; ++i) { a[i] *= xqg[d0 + i]; b[i] *= xqg[d0 + 8 + i]; }
    *(u32x4*)ptr = pack8(a); *(u32x4*)(ptr + 8) = pack8(b);
}

DI void memk_post_rows(bf16_t* MK, int gw, int ngw, const float* xkg, const float* xqg, float* mkp, int lane) {
    for (int row = gw; row < MEMR; row += 4 * ngw) {
        u32x4 w0[4], w1[4];
#pragma unroll
        for (int i = 0; i < 4; ++i) { const int r = row + i * ngw; if (r < MEMR) { const bf16_t* ptr = MK + (size_t)r * DM + lane * 16; w0[i] = *(const u32x4*)ptr; w1[i] = *(const u32x4*)(ptr + 8); } }
#pragma unroll
        for (int i = 0; i < 4; ++i) { const int r = row + i * ngw; if (r < MEMR) memk_post_row(MK, r, w0[i], w1[i], xkg, xqg, mkp, lane); }
    }
}

#define MFMA32(a, b, c) __builtin_amdgcn_mfma_f32_32x32x16_bf16((a), (b), (c), 0, 0, 0)
DI int crow(int r, int hi) { return (r & 3) + 8 * (r >> 2) + 4 * hi; }

DI void gate_unit(int un, int& cached_g, const bf16_t* Z, bf16_t* H, const float* Wsl, const float* gmb, const float* gmg, LAS unsigned char* lds, int tid, int wid, int lane) {
    const int b = un >> 6, n = (un >> 2) & 15, g = un & 3, row0 = b * SEQ + n * 128;
    LAS unsigned char* Ws = lds; LAS unsigned char* Gt = lds + 128 * 272;
    const int r32 = lane & 31, hi = lane >> 5, tblk = wid & 3, cp = wid >> 2;
    const int t = tblk * 32 + r32, row = row0 + t; const float bias = gmb[g * 128 + t];
    u32x2 uw[2][4];
#pragma unroll
    for (int cc = 0; cc < 2; ++cc)
#pragma unroll
        for (int rg = 0; rg < 4; ++rg) uw[cc][rg] = *(const u32x2*)(Z + (size_t)row * INC + 1536 + g * 128 + (2 * cp + cc) * 32 + 8 * rg + 4 * hi);
    if (g != cached_g) {
        cached_g = g;
        const float* wsrc = Wsl + (size_t)g * 128 * 128;
#pragma unroll
        for (int i = 0; i < 8; ++i) { const int idx = tid + NTHR * i, t = idx >> 5, s4 = (idx & 31) * 4; f32x4 v = *(const f32x4*)(wsrc + t * 128 + s4);
#pragma unroll
            for (int j = 0; j < 4; ++j) if (s4 + j > t) v[j] = 0.f;
            u32x2 w; w.x = pk2(v[0], v[1]); w.y = pk2(v[2], v[3]); *(LAS u32x2*)(Ws + t * 272 + s4 * 2) = w; }
    }
#pragma unroll
    for (int i = 0; i < 4; ++i) { const int idx = tid + NTHR * i, s = idx >> 4, ch = idx & 15;
        const u32x4 w = *(const u32x4*)(Z + (size_t)(row0 + s) * INC + 2048 + g * 128 + ch * 8); float v[8]; unpack8(w, v);
        float ss = 0.f;
#pragma unroll
        for (int j = 0; j < 8; ++j) ss += v[j] * v[j];
        ss += __shfl_xor(ss, 1); ss += __shfl_xor(ss, 2); ss += __shfl_xor(ss, 4); ss += __shfl_xor(ss, 8);
        const float rs = rstd_of(ss, 1.0f / 128.f);
#pragma unroll
        for (int j = 0; j < 8; j += 2) { const unsigned pw = pk2(v[j] * rs * gmg[ch * 8 + j], v[j + 1] * rs * gmg[ch * 8 + j + 1]);
            *(LAS bf16_t*)(Gt + (ch * 8 + j) * 272 + ((s ^ (ch << 3)) << 1)) = (bf16_t)(pw & 0xffffu); *(LAS bf16_t*)(Gt + (ch * 8 + j + 1) * 272 + ((s ^ (ch << 3)) << 1)) = (bf16_t)(pw >> 16); } }
    __syncthreads();
    f32x16 acc[2];
#pragma unroll
    for (int i = 0; i < 16; ++i) { acc[0][i] = 0.f; acc[1][i] = 0.f; }
    const int nks = 2 * (tblk + 1);
    for (int ks = 0; ks < nks; ++ks) {
        const bf16x8 bf = *(const LAS bf16x8*)(Ws + (tblk * 32 + r32) * 272 + (ks * 16 + hi * 8) * 2);
#pragma unroll
        for (int cc = 0; cc < 2; ++cc) { const int crow_ = (2 * cp + cc) * 32 + r32; const bf16x8 af = *(const LAS bf16x8*)(Gt + crow_ * 272 + (((ks * 2 + hi) ^ (crow_ >> 3)) << 4)); acc[cc] = MFMA32(af, bf, acc[cc]); }
    }
#pragma unroll
    for (int cc = 0; cc < 2; ++cc)
#pragma unroll
        for (int rg = 0; rg < 4; ++rg) { const int c0 = (2 * cp + cc) * 32 + 8 * rg + 4 * hi;
            const u32x2 uv = uw[cc][rg];
            u32x2 o; o.x = pk2(bflo(uv.x) * (acc[cc][4 * rg] + bias), bfhi(uv.x) * (acc[cc][4 * rg + 1] + bias)); o.y = pk2(bflo(uv.y) * (acc[cc][4 * rg + 2] + bias), bfhi(uv.y) * (acc[cc][4 * rg + 3] + bias));
            *(u32x2*)(H + (size_t)row * DM + 512 + g * 128 + c0) = o; }
    __syncthreads();
}
DI void gate_sample_unit(int un, const bf16_t* Z, bf16_t* H, const float* Wsl, const float* gmb, const float* gmg, float* gvs, LAS unsigned char* lds, int tid, int wid, int lane) {
    const int b = un >> 2, g = un & 3, row0 = RP + b * DSEQ;
    LAS float* gvn = (LAS float*)lds;
    for (int s = wid; s < DSEQ; s += NWAVES) {
        const unsigned w = *(const unsigned*)(Z + (size_t)(row0 + s) * INC + 2048 + g * 128 + 2 * lane);
        const float v0 = bflo(w), v1 = bfhi(w); const float ss = wave_sum(v0 * v0 + v1 * v1); const float rs = rstd_of(ss, 1.0f / 128.f);
        const float n0 = v0 * rs * gmg[2 * lane], n1 = v1 * rs * gmg[2 * lane + 1];
        gvn[s * 128 + 2 * lane] = n0; gvn[s * 128 + 2 * lane + 1] = n1;
        *(f32x2*)(gvs + (size_t)(b * DSEQ + s) * 512 + g * 128 + 2 * lane) = (f32x2){n0, n1};
    }
    LAS float* wl_ = gvn + DSEQ * 128;
    for (int i = tid; i < DSEQ * DSEQ; i += NTHR) wl_[(i >> 5) * 33 + (i & 31)] = Wsl[(size_t)g * 128 * 128 + (i >> 5) * 128 + (i & 31)];
    __syncthreads();
#pragma unroll
    for (int k = 0; k < 8; ++k) { const int idx = tid + NTHR * k, t = idx >> 7, c = idx & 127; float acc = 0.f;
        const LAS float* wr_ = wl_ + t * 33;
#pragma unroll 16
        for (int s = 0; s < DSEQ; ++s) acc += (s <= t ? wr_[s] : 0.f) * gvn[s * 128 + c];
        const float uu = bflo((unsigned)Z[(size_t)(row0 + t) * INC + 1536 + g * 128 + c]);
        const unsigned pw = pk2(uu * (acc + gmb[g * 128 + t]), 0.f);
        H[(size_t)(row0 + t) * DM + 512 + g * 128 + c] = (bf16_t)(pw & 0xffffu); }
    __syncthreads();
}

DI void diff_attn_unit(int b, int h, int qb, const bf16_t* Z, const bf16_t* VT, bf16_t* H, float lam, const float* subg, float oscale, LAS unsigned char* lds, int wid, int lane) {
    const int r32 = lane & 31, hi = lane >> 5, mp = wid >> 2, wq = wid & 3;
    const int qrow = b * SEQ + qb * 128 + wq * 32 + r32;
    bf16x8 qf[4];
#pragma unroll
    for (int ks = 0; ks < 4; ++ks) qf[ks] = *(const bf16x8*)(Z + (size_t)qrow * INC + h * 128 + mp * 64 + ks * 16 + hi * 8);
    const int ntile = 2 * qb + 2, mylast = 2 * qb + (wq >> 1);
    const bf16_t* kg[2]; const bf16_t* vg[2];
#pragma unroll
    for (int i = 0; i < 2; ++i) { const int q = i * 8 + wid;
        { const int row = 4 * q + (lane >> 4), c = (lane & 15) ^ (row & 15); kg[i] = Z + (size_t)(b * SEQ + row) * INC + 512 + h * 128 + c * 8; }
        { const int row = 8 * q + (lane >> 3), c = (lane & 7) ^ (row & 7); vg[i] = VT + (size_t)((b * 4 + h) * 128 + row) * SEQ + c * 8; } }
#define DA_ISSUE(t, buf) do { _Pragma("unroll") for (int i_ = 0; i_ < 2; ++i_) { \
        __builtin_amdgcn_global_load_lds((const unsigned*)(kg[i_] + (size_t)(t) * 64 * INC), (LAS unsigned*)(lds + (buf) * 32768 + (i_ * 8 + wid) * 1024), 16, 0, 0); \
        __builtin_amdgcn_global_load_lds((const unsigned*)(vg[i_] + (size_t)(t) * 64), (LAS unsigned*)(lds + (buf) * 32768 + 16384 + (i_ * 8 + wid) * 1024), 16, 0, 0); } } while (0)
    f32x16 O[4];
#pragma unroll
    for (int d = 0; d < 4; ++d)
#pragma unroll
        for (int i = 0; i < 16; ++i) O[d][i] = 0.f;
    float ls = 0.f;
    DA_ISSUE(0, 0);
    asm volatile("s_waitcnt vmcnt(0)" ::: "memory"); __syncthreads();
    for (int t = 0; t < ntile; ++t) {
        const int buf = t & 1;
        if (t + 1 < ntile) DA_ISSUE(t + 1, buf ^ 1);
        if (t <= mylast) {
            const LAS unsigned char* kb = lds + buf * 32768; const LAS unsigned char* vb = kb + 16384;
            f32x16 s0, s1;
#pragma unroll
            for (int i = 0; i < 16; ++i) { s0[i] = 0.f; s1[i] = 0.f; }
#pragma unroll
            for (int ks = 0; ks < 4; ++ks) { const int c = mp * 8 + ks * 2 + hi; const int off = r32 * 256 + ((c ^ (r32 & 15)) << 4);
                const bf16x8 a0 = *(const LAS bf16x8*)(kb + off), a1 = *(const LAS bf16x8*)(kb + 8192 + off);
                s0 = MFMA32(a0, qf[ks], s0); s1 = MFMA32(a1, qf[ks], s1); }
#pragma unroll
            for (int i = 0; i < 16; ++i) { s0[i] = __builtin_amdgcn_exp2f(s0[i]); s1[i] = __builtin_amdgcn_exp2f(s1[i]); ls += s0[i] + s1[i]; }
            bf16x8 pb[4]; u32x4 w;
            w.x = pk2(s0[0], s0[1]); w.y = pk2(s0[2], s0[3]); w.z = pk2(s0[4], s0[5]); w.w = pk2(s0[6], s0[7]); pb[0] = __builtin_bit_cast(bf16x8, w);
            w.x = pk2(s0[8], s0[9]); w.y = pk2(s0[10], s0[11]); w.z = pk2(s0[12], s0[13]); w.w = pk2(s0[14], s0[15]); pb[1] = __builtin_bit_cast(bf16x8, w);
            w.x = pk2(s1[0], s1[1]); w.y = pk2(s1[2], s1[3]); w.z = pk2(s1[4], s1[5]); w.w = pk2(s1[6], s1[7]); pb[2] = __builtin_bit_cast(bf16x8, w);
            w.x = pk2(s1[8], s1[9]); w.y = pk2(s1[10], s1[11]); w.z = pk2(s1[12], s1[13]); w.w = pk2(s1[14], s1[15]); pb[3] = __builtin_bit_cast(bf16x8, w);
#pragma unroll
            for (int d = 0; d < 4; ++d)
#pragma unroll
                for (int j = 0; j < 4; ++j) { const int row = 32 * d + r32; const LAS unsigned char* rp = vb + row * 128 + 8 * hi;
                    const u32x2 lo = *(const LAS u32x2*)(rp + (((2 * j) ^ (row & 7)) << 4)), hh = *(const LAS u32x2*)(rp + (((2 * j + 1) ^ (row & 7)) << 4));
                    const u32x4 wv = {lo.x, lo.y, hh.x, hh.y}; const bf16x8 a = __builtin_bit_cast(bf16x8, wv);
                    O[d] = MFMA32(a, pb[j], O[d]); }
        }
        asm volatile("s_waitcnt vmcnt(0)" ::: "memory"); __syncthreads();
    }
#undef DA_ISSUE
    ls += __shfl_xor(ls, 32);
    LAS float* xch = (LAS float*)(lds + wq * 16384);
    if (mp == 1) { const float i1 = lam / ls;
#pragma unroll
        for (int d = 0; d < 4; ++d)
#pragma unroll
            for (int i = 0; i < 16; ++i) xch[(d * 16 + i) * 64 + lane] = O[d][i] * i1; }
    __syncthreads();
    if (mp == 0) { const float i0 = 1.0f / ls; float ss = 0.f;
#pragma unroll
        for (int d = 0; d < 4; ++d)
#pragma unroll
            for (int i = 0; i < 16; ++i) { const float o = O[d][i] * i0 - xch[(d * 16 + i) * 64 + lane]; O[d][i] = o; ss += o * o; }
        ss += __shfl_xor(ss, 32);
        const float rs = rstd_of(ss, 1.0f / 128.f) * oscale;
        bf16_t* hp = H + (size_t)qrow * DM + h * 128;
#pragma unroll
        for (int d = 0; d < 4; ++d)
#pragma unroll
            for (int rg = 0; rg < 4; ++rg) { const int d0 = 32 * d + 8 * rg + 4 * hi; const f32x4 g4 = *(const f32x4*)(subg + d0);
                u32x2 o; o.x = pk2(O[d][4 * rg] * rs * g4[0], O[d][4 * rg + 1] * rs * g4[1]); o.y = pk2(O[d][4 * rg + 2] * rs * g4[2], O[d][4 * rg + 3] * rs * g4[3]);
                *(u32x2*)(hp + d0) = o; } }
    __syncthreads();
}

DI void diff_attn_sample_pair(int it, int hf, int l, const float* cdk, const float* cdv, const float* outp, const bf16_t* Z, bf16_t* H, float lam, const float* subg, float oscale, LAS unsigned char* lds, int wid, int lane) {
    const int srow = it >> 2, h = it & 3, b = srow >> 5;
    LAS float* qs = (LAS float*)(lds + wid * 16384);
    LAS float* ps = qs + 128; LAS float* xst = ps + 2 * 544; LAS float* xacc = xst + 4;
    const LAS float* ost = (const LAS float*)(lds + (wid ^ 1) * 16384) + 128 + 2 * 544; const LAS float* oacc = ost + 4;
    const int NKH = 544, nkl = hf ? 544 : 512, j0g = hf * 512;
    { const unsigned w = *(const unsigned*)(Z + (size_t)(RP + srow) * INC + h * 128 + 2 * lane); qs[2 * lane] = bflo(w); qs[2 * lane + 1] = bfhi(w); }
    asm volatile("s_waitcnt lgkmcnt(0)" ::: "memory");
    const float* ck = cdk + (size_t)(l * DB + b) * PAST * 512 + h * 128;
    const float* nk = outp + O_DKS + (size_t)(l * DB + b) * DSEQ * 512 + h * 128;
    float mx[2] = {-3.0e38f, -3.0e38f};
    for (int jj = lane; jj < nkl; jj += 64) { const int j = j0g + jj;
        const float* kp = j < PAST ? ck + (size_t)j * 512 : nk + (size_t)(j - PAST) * 512;
#pragma unroll
        for (int m = 0; m < 2; ++m) { float dot = 0.f;
#pragma unroll
            for (int d = 0; d < 64; d += 4) { const f32x4 kv = *(const f32x4*)(kp + m * 64 + d); dot += kv[0] * qs[m * 64 + d] + kv[1] * qs[m * 64 + d + 1] + kv[2] * qs[m * 64 + d + 2] + kv[3] * qs[m * 64 + d + 3]; }
            ps[m * NKH + jj] = dot; mx[m] = fmaxf(mx[m], dot); }
    }
    float lsum[2], mm[2];
#pragma unroll
    for (int m = 0; m < 2; ++m) { mm[m] = wave_max(mx[m]); float s = 0.f;
        for (int jj = lane; jj < nkl; jj += 64) { const float e = __builtin_amdgcn_exp2f(ps[m * NKH + jj] - mm[m]); ps[m * NKH + jj] = e; s += e; }
        lsum[m] = wave_sum(s); }
    asm volatile("s_waitcnt lgkmcnt(0)" ::: "memory");
    const float* cv = cdv + (size_t)(l * DB + b) * PAST * 512 + h * 128 + 2 * lane;
    const float* nv = outp + O_DVS + (size_t)(l * DB + b) * DSEQ * 512 + h * 128 + 2 * lane;
    f32x2 a0 = {0.f, 0.f}, a1 = {0.f, 0.f};
#pragma unroll 1
    for (int jb = 0; jb < nkl; jb += 32) {
        const float* vp = (j0g + jb) < PAST ? cv + (size_t)(j0g + jb) * 512 : nv + (size_t)(j0g + jb - PAST) * 512;
        f32x2 v[32];
#pragma unroll
        for (int j = 0; j < 32; ++j) v[j] = *(const f32x2*)(vp + (size_t)j * 512);
#pragma unroll
        for (int j = 0; j < 32; ++j) { a0 += v[j] * ps[jb + j]; a1 += v[j] * ps[NKH + jb + j]; }
    }
    if (lane == 0) { xst[0] = mm[0]; xst[1] = mm[1]; xst[2] = lsum[0]; xst[3] = lsum[1]; }
    *(LAS f32x4*)(xacc + 4 * lane) = (f32x4){a0[0], a0[1], a1[0], a1[1]};
    __syncthreads();
    { const float om0 = ost[0], om1 = ost[1], ol0 = ost[2], ol1 = ost[3]; const f32x4 oa = *(const LAS f32x4*)(oacc + 4 * lane);
      const float M0 = fmaxf(mm[0], om0), M1 = fmaxf(mm[1], om1);
      const float f0 = __builtin_amdgcn_exp2f(mm[0] - M0), g0 = __builtin_amdgcn_exp2f(om0 - M0), f1 = __builtin_amdgcn_exp2f(mm[1] - M1), g1 = __builtin_amdgcn_exp2f(om1 - M1);
      const float l0 = hf ? ol0 * g0 + lsum[0] * f0 : lsum[0] * f0 + ol0 * g0, l1 = hf ? ol1 * g1 + lsum[1] * f1 : lsum[1] * f1 + ol1 * g1;
      const float n00 = hf ? oa[0] * g0 + a0[0] * f0 : a0[0] * f0 + oa[0] * g0, n01 = hf ? oa[1] * g0 + a0[1] * f0 : a0[1] * f0 + oa[1] * g0;
      const float n10 = hf ? oa[2] * g1 + a1[0] * f1 : a1[0] * f1 + oa[2] * g1, n11 = hf ? oa[3] * g1 + a1[1] * f1 : a1[1] * f1 + oa[3] * g1;
      const float i0 = 1.0f / l0, i1 = lam / l1;
      const float o0 = n00 * i0 - n10 * i1, o1 = n01 * i0 - n11 * i1;
      const float ss = wave_sum(o0 * o0 + o1 * o1); const float rs = rstd_of(ss, 1.0f / 128.f) * oscale;
      if (hf == 0) *(unsigned*)(H + (size_t)(RP + srow) * DM + h * 128 + 2 * lane) = pk2(o0 * rs * subg[2 * lane], o1 * rs * subg[2 * lane + 1]); }
}

DI void cross_attn_sample_pair(int it, int hf, int l, const float* cmk, const float* cmv, const bf16_t* Q, const acc_t* ssqq, const float* xqg, bf16_t* H, LAS unsigned char* lds, int wid, int lane) {
    const int srow = it >> 2, h = it & 3, b = srow >> 5, row = RP + srow;
    LAS float* qs = (LAS float*)(lds + wid * 16384);
    LAS float* ps = qs + 256; LAS float* xst = ps + 128; LAS float* xacc = xst + 4;
    const LAS float* ost = (const LAS float*)(lds + (wid ^ 1) * 16384) + 256 + 128; const LAS float* oacc = ost + 4;
    { const u32x2 w = *(const u32x2*)(Q + (size_t)row * DM + h * 256 + 4 * lane); const float rs = rstd_of(acc_get(ssqq + (size_t)row * 4 + h, 1.0f / SSQ_SCALE), 1.0f / 256.f) * XSCALE;
      const f32x4 g4 = *(const f32x4*)(xqg + 4 * lane);
      qs[4 * lane] = bflo(w.x) * rs * g4[0]; qs[4 * lane + 1] = bfhi(w.x) * rs * g4[1]; qs[4 * lane + 2] = bflo(w.y) * rs * g4[2]; qs[4 * lane + 3] = bfhi(w.y) * rs * g4[3]; }
    asm volatile("s_waitcnt lgkmcnt(0)" ::: "memory");
    const float* ck = cmk + ((size_t)(l * DB + b) * 256 + hf * 128) * DM + h * 256;
    float sc[2]; float mx = -3.0e38f;
#pragma unroll
    for (int k = 0; k < 2; ++k) { const float* kp = ck + (size_t)(lane + 64 * k) * DM; float dot = 0.f;
#pragma unroll 1
        for (int d0 = 0; d0 < 256; d0 += 64) { f32x4 kv[16];
#pragma unroll
            for (int d = 0; d < 16; ++d) kv[d] = *(const f32x4*)(kp + d0 + 4 * d);
#pragma unroll
            for (int d = 0; d < 16; ++d) dot += kv[d][0] * qs[d0 + 4 * d] + kv[d][1] * qs[d0 + 4 * d + 1] + kv[d][2] * qs[d0 + 4 * d + 2] + kv[d][3] * qs[d0 + 4 * d + 3]; }
        sc[k] = dot; mx = fmaxf(mx, dot); }
    mx = wave_max(mx); float s = 0.f;
#pragma unroll
    for (int k = 0; k < 2; ++k) { const float e = __builtin_amdgcn_exp2f(sc[k] - mx); ps[lane + 64 * k] = e; s += e; }
    s = wave_sum(s);
    asm volatile("s_waitcnt lgkmcnt(0)" ::: "memory");
    const float* cv = cmv + ((size_t)(l * DB + b) * 256 + hf * 128) * DM + h * 256 + 4 * lane;
    f32x4 acc = {0.f, 0.f, 0.f, 0.f};
#pragma unroll 1
    for (int jb = 0; jb < 128; jb += 16) { f32x4 v[16];
#pragma unroll
        for (int j = 0; j < 16; ++j) v[j] = *(const f32x4*)(cv + (size_t)(jb + j) * DM);
#pragma unroll
        for (int j = 0; j < 16; ++j) acc += v[j] * ps[jb + j]; }
    if (lane == 0) { xst[0] = mx; xst[1] = s; }
    *(LAS f32x4*)(xacc + 4 * lane) = acc;
    __syncthreads();
    { const float om = ost[0], os = ost[1]; const f32x4 oa = *(const LAS f32x4*)(oacc + 4 * lane);
      const float M = fmaxf(mx, om), f = __builtin_amdgcn_exp2f(mx - M), g = __builtin_amdgcn_exp2f(om - M);
      const float lt = hf ? os * g + s * f : s * f + os * g;
      const f32x4 n = hf ? oa * g + acc * f : acc * f + oa * g;
      const float inv = 1.0f / lt;
      if (hf == 0) { u32x2 o; o.x = pk2(n[0] * inv, n[1] * inv); o.y = pk2(n[2] * inv, n[3] * inv); *(u32x2*)(H + (size_t)row * DM + h * 256 + 4 * lane) = o; } }
}

DI void act_fix_item(int item, const bf16_t* GS, const bf16_t* US, bf16_t* A2, const float* cw, const float* cb) {
    const int cch = item % (DFF / 8), rest = item / (DFF / 8), f = rest & 1, k = rest >> 1, c0 = cch * 8, row = 64 * k + f;
    const bool seq_start = (k & 31) == 0;
    float gm2[8], gm1[8], g[8], up[8], a[8];
    if (f == 0) {
        if (seq_start) {
#pragma unroll
            for (int j = 0; j < 8; ++j) { gm2[j] = 0.f; gm1[j] = 0.f; } }
        else { unpack8(*(const u32x4*)(GS + ((size_t)(k - 1) * 4 + 0) * DFF + c0), gm2); unpack8(*(const u32x4*)(GS + ((size_t)(k - 1) * 4 + 1) * DFF + c0), gm1); }
        unpack8(*(const u32x4*)(GS + ((size_t)k * 4 + 2) * DFF + c0), g);
    } else {
        if (seq_start) {
#pragma unroll
            for (int j = 0; j < 8; ++j) gm2[j] = 0.f; }
        else unpack8(*(const u32x4*)(GS + ((size_t)(k - 1) * 4 + 1) * DFF + c0), gm2);
        unpack8(*(const u32x4*)(GS + ((size_t)k * 4 + 2) * DFF + c0), gm1); unpack8(*(const u32x4*)(GS + ((size_t)k * 4 + 3) * DFF + c0), g);
    }
    unpack8(*(const u32x4*)(US + ((size_t)k * 2 + f) * DFF + c0), up);
#pragma unroll
    for (int j = 0; j < 8; ++j) a[j] = silu_f(cb[c0 + j] + cw[c0 + j] * gm2[j] + cw[DFF + c0 + j] * gm1[j] + cw[2 * DFF + c0 + j] * g[j]) * up[j];
    *(u32x4*)(A2 + (size_t)row * DFF + c0) = pack8(a);
}
DI void act_sample_item(int item, const bf16_t* SG, bf16_t* A2s, const float* cw, const float* cb, const float* hist  ) {
    const int cch = item % (DFF / 8), sb = item / (DFF / 8), c0 = cch * 8;
    float w0[8], w1[8], w2[8], bb[8], g2[8], g1[8], g0[8], up[8];
#pragma unroll
    for (int j = 0; j < 8; ++j) { w0[j] = cw[c0 + j]; w1[j] = cw[DFF + c0 + j]; w2[j] = cw[2 * DFF + c0 + j]; bb[j] = cb[c0 + j]; }
    { const float* hp = hist + (size_t)sb * 2 * DFF + c0;
#pragma unroll
      for (int j = 0; j < 8; ++j) { g0[j] = hp[j]; g1[j] = hp[DFF + j]; } }
#pragma unroll 1
    for (int r0 = 0; r0 < DSEQ; r0 += 4) {
        u32x4 gw[4], uw[4];
#pragma unroll
        for (int i = 0; i < 4; ++i) { const bf16_t* gp = SG + (size_t)(sb * DSEQ + r0 + i) * UPC + c0; gw[i] = *(const u32x4*)gp; uw[i] = *(const u32x4*)(gp + DFF); }
#pragma unroll
        for (int i = 0; i < 4; ++i) { unpack8(gw[i], g2); unpack8(uw[i], up);
            float a[8];
#pragma unroll
            for (int j = 0; j < 8; ++j) { const float c = bb[j] + w0[j] * g0[j] + w1[j] * g1[j] + w2[j] * g2[j]; a[j] = silu_f(c) * up[j]; g0[j] = g1[j]; g1[j] = g2[j]; }
            *(u32x4*)(A2s + (size_t)(sb * DSEQ + r0 + i) * DFF + c0) = pack8(a); }
    }
}
#define XB_TMO      128
#define XB_XCNT(j)  (256  + 64 * (j))
#define XB_XSUB(j)  (1280 + 64 * (j))
#define XB_XGEN(j)  (2304 + 64 * (j))
#define XB_TOP      3328
#define XB_TOPGEN   3392
#define XCD_BAR_WORDS 3456
#define XB_SPIN_CAP (1u << 18)

DI unsigned xb_ld(unsigned* p)              { return __hip_atomic_load(p, __ATOMIC_RELAXED, __HIP_MEMORY_SCOPE_AGENT); }
DI unsigned xb_add(unsigned* p, unsigned v) { return __hip_atomic_fetch_add(p, v, __ATOMIC_RELAXED, __HIP_MEMORY_SCOPE_AGENT); }
DI unsigned xb_xcc_id() { return (unsigned)__builtin_amdgcn_s_getreg((3 << 11) | 20) & 0xFu; }
#define XB_SPIN(cond, bar) do { unsigned _sp = 0; while (cond) { __builtin_amdgcn_s_sleep(1); \
    if ((++_sp & 255u) == 0u) { if (xb_ld(&(bar)[XB_TMO])) break; if (_sp > XB_SPIN_CAP) { atomicAdd(&(bar)[XB_TMO], 1u); break; } } } } while (0)

struct XcdBarrier {
    unsigned* bar; unsigned x;
    volatile LAS unsigned* st;
};

DI bool xb_tid0(int wid) { unsigned m_ = ~0u; int w_ = wid; asm volatile("" : "+s"(m_), "+s"(w_)); return w_ == 0 && __builtin_amdgcn_mbcnt_hi(m_, __builtin_amdgcn_mbcnt_lo(m_, 0u)) == 0u; }
DI XcdBarrier xcd_barrier_post(unsigned* bar, volatile LAS unsigned* st, int wid) {
    XcdBarrier b; b.bar = bar; b.x = xb_xcc_id(); b.st = st;
    if (xb_tid0(wid)) (void)xb_add(&bar[XB_XCNT(b.x)], 1u);
    return b;
}
DI void xcd_barrier_complete(unsigned* bar, unsigned x, unsigned& nloc, unsigned& nx) {
    const unsigned G = gridDim.x * gridDim.y * gridDim.z;
    unsigned sum, cnt, mine, sp = 0u;
    for (;;) {
        sum = 0u; cnt = 0u; mine = 0u;
#pragma unroll
        for (unsigned j = 0; j < 16; ++j) { const unsigned c = xb_ld(&bar[XB_XCNT(j)]); sum += c; cnt += (c > 0u) ? 1u : 0u; mine = (j == x) ? c : mine; }
        if (sum == G) break;
        __builtin_amdgcn_s_sleep(1);
        if ((++sp & 255u) == 0u) { if (xb_ld(&bar[XB_TMO])) break; if (sp > XB_SPIN_CAP) { atomicAdd(&bar[XB_TMO], 1u); break; } }
    }
    nloc = mine > 0u ? mine : 1u; nx = cnt > 0u ? cnt : 1u;
}

DI void xcd_barrier(const XcdBarrier& b, int wid) {
    asm volatile("s_waitcnt vmcnt(0)" ::: "memory");
    __syncthreads();
    if (xb_tid0(wid)) {
        unsigned* bar = b.bar;
        __builtin_amdgcn_s_waitcnt(0);
        unsigned nloc = b.st[0], nx = b.st[1];
        if (nloc == 0u) { xcd_barrier_complete(bar, b.x, nloc, nx); b.st[0] = nloc; b.st[1] = nx; }
        const unsigned old = xb_add(&bar[XB_XSUB(b.x)], 1u);
        const unsigned gen = old / nloc;
        if (old + 1u == (gen + 1u) * nloc) {
            __builtin_amdgcn_fence(__ATOMIC_RELEASE, "agent");
            asm volatile("s_waitcnt vmcnt(0)" ::: "memory");
            const unsigned og = xb_add(&bar[XB_TOP], 1u);
            const unsigned tg = og / nx;
            if (og + 1u == (tg + 1u) * nx) xb_add(&bar[XB_TOPGEN], 1u);
            else XB_SPIN(xb_ld(&bar[XB_TOPGEN]) == tg, bar);
            __builtin_amdgcn_fence(__ATOMIC_ACQUIRE, "agent");
            xb_add(&bar[XB_XGEN(b.x)], 1u);
            asm volatile("s_waitcnt vmcnt(0)" ::: "memory");
        } else {
            XB_SPIN(xb_ld(&bar[XB_XGEN(b.x)]) == gen, bar);
            __builtin_amdgcn_fence(__ATOMIC_ACQUIRE, "agent");
            asm volatile("s_waitcnt vmcnt(0)" ::: "memory");
        }
    }
    __syncthreads();
}

__global__ void __launch_bounds__(NTHR, 2) fwd_megakernel(Params p_unused) {
    extern __shared__ __attribute__((aligned(16))) unsigned char lds_raw[];
    LAS unsigned char* lds = (LAS unsigned char*)lds_raw;
    cg::grid_group grid = cg::this_grid();
    const int G = gridDim.x, bx = blockIdx.x, ngw = G * NWAVES;
const int wid_s = __builtin_amdgcn_readfirstlane((int)threadIdx.x >> 6);
#define LAUNDER_T int wid = wid_s, bx_ = bx; asm volatile("" : "+s"(wid), "+s"(bx_)); unsigned m1_ = ~0u; asm volatile("" : "+s"(m1_)); const int lane = (int)__builtin_amdgcn_mbcnt_hi(m1_, __builtin_amdgcn_mbcnt_lo(m1_, 0u)); const int tid = (wid << 6) | lane, gw = bx * NWAVES + wid; (void)gw;
    { LAUNDER_T
      if (bx == 0) { unsigned* bw = (unsigned*)(kparams()->ws + WS_BAR); for (int i = tid; i < XCD_BAR_WORDS; i += NTHR) bw[i] = 0u; }
      if (tid < 2) ((LAS unsigned*)(lds + 131072 + 256))[tid] = 0u;
      phase_prologue(lds, gw, ngw, wid, lane); }
    grid.sync();
    XcdBarrier xbar = xcd_barrier_post((unsigned*)(kparams()->ws + WS_BAR), (volatile LAS unsigned*)(lds + 131072 + 256), wid_s);
#define GRID_SYNC() xcd_barrier(xbar, wid_s)

#define LAUNDER_L LAUNDER_T int l = l_; asm volatile("" : "+s"(l)); const KParams p = kparams(); unsigned char* ws = p->ws; float* outp = p->out; (void)outp;
#define WL ((const bf16_t*)(ws + WS_W) + (size_t)l * WL_STRIDE)
#define SSQ(n) ((acc_t*)(ws + WS_SSQ) + (size_t)(l * 3 + (n)) * R)
    for (int l_ = 0; l_ < DEPTH; ++l_) {
        { LAUNDER_L
          { pg8::SchedStd S; S.init((const bf16_t*)(ws + WS_XB), DM, WL + WL_IN, DM, R, INC, G, bx_);
            pg8::EpiIn E{(bf16_t*)(ws + WS_Z), SSQ(0), outp + O_DVP + (size_t)l * RP * 512, outp + O_DVS + (size_t)l * RS * 512, (bf16_t*)(ws + WS_VT), (LAS float*)(lds + 131072 + 1024), p->in[10] + l * 64, p->in[11] + l * 64, outp + O_DKP + (size_t)l * RP * 512, outp + O_DKS + (size_t)l * RS * 512, (const float*)(ws + WS_END)}; pg8::gemm_phase(lds, tid, DM, DM, DM, S, E); }
          if (l == 0) { pg8::SchedStd S; S.init((const bf16_t*)(ws + WS_MB), DM, WL + WL_K, DM, MEMR, 2 * DM, G, bx_);
            pg8::EpiKV E{(bf16_t*)(ws + WS_MK), (const float*)(ws + WS_SSQM), outp + O_MVP + (size_t)l * MEMR * DM, (bf16_t*)(ws + WS_MVT)}; pg8::gemm_phase(lds, tid, DM, DM, DM, S, E); } }
        GRID_SYNC();

        { LAUNDER_L
            bf16_t* Z = (bf16_t*)(ws + WS_Z); bf16_t* H = (bf16_t*)(ws + WS_H); bf16_t* MK = (bf16_t*)(ws + WS_MK);
            float* mkp = outp + O_MKP + (size_t)l * MEMR * DM;
            memk_post_rows(MK, gw, ngw, p->in[28] + l * 256, p->in[27] + l * 256, mkp, lane);
            acc_t* ssqq = (acc_t*)(ws + WS_SSQQ); acc_t* lsum = (acc_t*)(ws + WS_LSUM);
            for (int i = gw * 64 + lane; i < R * 4; i += ngw * 64) ssqq[i] = 0ull;
            for (int i = gw * 64 + lane; i < RP * 4; i += ngw * 64) lsum[i] = 0ull;
            __syncthreads();
            const float* Wsl = p->in[18] + (size_t)l * 4 * 128 * 128; const float* gmb = p->in[19] + l * 512; const float* gmg = p->in[17] + l * 128;
            int cached_g = -1;
            for (int un = bx; un < NBATCH * 16 * 4; un += G) gate_unit(un, cached_g, Z, H, Wsl, gmb, gmg, lds, tid, wid, lane);
            for (int un = bx; un < DB * 4; un += G) gate_sample_unit(un, Z, H, Wsl, gmb, gmg, outp + O_GVS + (size_t)l * RS * 512, lds, tid, wid, lane);
        }
        GRID_SYNC();

        { LAUNDER_L
            const bf16_t* Z = (const bf16_t*)(ws + WS_Z); bf16_t* H = (bf16_t*)(ws + WS_H); const bf16_t* VT = (const bf16_t*)(ws + WS_VT);
            const float lam_init = lam_init_of(l);
            float lam;
            { const float a = wave_sum(p->in[12][l * 64 + lane] * p->in[13][l * 64 + lane]), b = wave_sum(p->in[14][l * 64 + lane] * p->in[15][l * 64 + lane]);
              lam = __builtin_bit_cast(float, __builtin_amdgcn_readfirstlane(__builtin_bit_cast(int, expf(a) - expf(b) + lam_init))); }
            const float* subg = p->in[16] + l * 128; const float oscale = 1.0f - lam_init;
            for (int pr = bx; pr < NBATCH * 4 * 8; pr += G) { const int bh = pr >> 3, s = pr & 7;
                diff_attn_unit(bh >> 2, bh & 3, s, Z, VT, H, lam, subg, oscale, lds, wid, lane);
                diff_attn_unit(bh >> 2, bh & 3, 15 - s, Z, VT, H, lam, subg, oscale, lds, wid, lane); }
            for (int base = bx * 4; base < RS * 4; base += G * 4) { diff_attn_sample_pair(base + (wid >> 1), wid & 1, l, p->in[2], p->in[3], outp, Z, H, lam, subg, oscale, lds, wid, lane); __syncthreads(); }
        }
        GRID_SYNC();

        { LAUNDER_L pg8::SchedStd S; S.init((const bf16_t*)(ws + WS_H), DM, WL + WL_OUT, DM, R, DM, G, bx_); pg8::EpiRes E{nullptr, (bf16_t*)(ws + WS_XB), SSQ(1)}; pg8::gemm_phase(lds, tid, DM, DM, DM, S, E); }
        if (l_ + 1 < DEPTH && bx >= 4) { LAUNDER_T int ln = l_ + 1; asm volatile("" : "+s"(ln));
            convert_layer_weights(ln, 0, (LAS float*)(lds + wid * 16384), (bx - 4) * NWAVES + wid, (G - 4) * NWAVES, lane); }
        GRID_SYNC();

        { LAUNDER_L pg8::SchedStd S; S.init((const bf16_t*)(ws + WS_XB), DM, WL + WL_Q, DM, R, DM, G, bx_); pg8::EpiQ E{(bf16_t*)(ws + WS_Q), SSQ(1), (acc_t*)(ws + WS_SSQQ)}; pg8::gemm_phase(lds, tid, DM, DM, DM, S, E); }
        if (l_ + 1 < DEPTH && bx >= 4) { LAUNDER_T int ln = l_ + 1; asm volatile("" : "+s"(ln));
            convert_layer_weights(ln, 1, (LAS float*)(lds + wid * 16384), (bx - 4) * NWAVES + wid, (G - 4) * NWAVES, lane); }
        GRID_SYNC();

        { LAUNDER_L
          { pg8::SchedX S{G, bx_, (const char*)(ws + WS_Q), (const char*)(ws + WS_MK), (size_t)256 * DM * 2, (size_t)256 * 2}; pg8::EpiS E{(bf16_t*)(ws + WS_P), (const acc_t*)(ws + WS_SSQQ), (acc_t*)(ws + WS_LSUM)}; pg8::gemm_phase(lds, tid, 256, DM, DM, S, E); }
          for (int base = bx * 4; base < RS * 4; base += G * 4) { cross_attn_sample_pair(base + (wid >> 1), wid & 1, l, p->in[4], p->in[5], (const bf16_t*)(ws + WS_Q), (const acc_t*)(ws + WS_SSQQ), p->in[27] + l * 256, (bf16_t*)(ws + WS_H), lds, wid, lane); __syncthreads(); } }

        { LAUNDER_L pg8::SchedX S{G, bx_, (const char*)(ws + WS_P), (const char*)(ws + WS_MVT), (size_t)DM * 256 * 2, (size_t)256 * 256 * 2}; pg8::EpiPV E{(bf16_t*)(ws + WS_H), (const acc_t*)(ws + WS_LSUM)}; pg8::gemm_phase(lds, tid, 256, DM, 256, S, E); }
        GRID_SYNC();

        { LAUNDER_L pg8::SchedStd S; S.init((const bf16_t*)(ws + WS_H), DM, WL + WL_O, DM, R, DM, G, bx_); pg8::EpiRes E{nullptr, (bf16_t*)(ws + WS_XB), SSQ(2)}; pg8::gemm_phase(lds, tid, DM, DM, DM, S, E); }
        if (l_ + 1 < DEPTH && bx >= 4) { LAUNDER_T int ln = l_ + 1; asm volatile("" : "+s"(ln));
            convert_layer_weights(ln, 2, (LAS float*)(lds + wid * 16384), (bx - 4) * NWAVES + wid, (G - 4) * NWAVES, lane); }
        GRID_SYNC();

        { LAUNDER_L pg8::SchedStd S; S.init((const bf16_t*)(ws + WS_XB), DM, WL + WL_UP, DM, R, UPC, G, bx_);
          pg8::EpiUpAct E{(bf16_t*)(ws + WS_A2), SSQ(2), (bf16_t*)(ws + WS_GS), (bf16_t*)(ws + WS_US), (bf16_t*)(ws + WS_SG), p->in[31] + (size_t)l * 3 * DFF, p->in[32] + (size_t)l * DFF,
                              outp + O_FCP + (size_t)l * NBATCH * 2 * DFF, outp + O_FCS + (size_t)l * DB * 2 * DFF}; pg8::gemm_phase(lds, tid, DM, DM, DM, S, E); }
        GRID_SYNC();

        { LAUNDER_L
            const float* cw = p->in[31] + (size_t)l * 3 * DFF; const float* cb = p->in[32] + (size_t)l * DFF; const float* hist = p->in[6] + (size_t)l * DB * 2 * DFF;
            for (int item = bx * NTHR + tid; item < (RP / 64) * 2 * (DFF / 8); item += G * NTHR) act_fix_item(item, (const bf16_t*)(ws + WS_GS), (const bf16_t*)(ws + WS_US), (bf16_t*)(ws + WS_A2), cw, cb);
            for (int item = bx * NTHR + tid; item < DB * (DFF / 8); item += G * NTHR) act_sample_item(item, (const bf16_t*)(ws + WS_SG), (bf16_t*)(ws + WS_A2) + (size_t)RP * DFF, cw, cb, hist);
        }
        GRID_SYNC();

        { LAUNDER_L pg8::SchedStd S; S.init((const bf16_t*)(ws + WS_A2), DFF, WL + WL_DN, DFF, R, DM, G, bx_);
          pg8::EpiRes E{(l + 1 < DEPTH) ? nullptr : outp + O_Y, (bf16_t*)(ws + WS_XB), (l + 1 < DEPTH) ? (acc_t*)(ws + WS_SSQ) + (size_t)((l + 1) * 3) * R : nullptr}; pg8::gemm_phase(lds, tid, DFF, DFF, DFF, S, E); }
        { LAUNDER_L
          if (l + 1 < DEPTH) { const bf16_t* wn = (const bf16_t*)(ws + WS_W) + (size_t)(l + 1) * WL_STRIDE;
            pg8::SchedStd S2; S2.init((const bf16_t*)(ws + WS_MB), DM, wn + WL_K, DM, MEMR, 2 * DM, G - 4, bx_ - 4);
            pg8::EpiKV E2{(bf16_t*)(ws + WS_MK), (const float*)(ws + WS_SSQM), outp + O_MVP + (size_t)(l + 1) * MEMR * DM, (bf16_t*)(ws + WS_MVT)}; pg8::gemm_phase(lds, tid, DM, DM, DM, S2, E2); } }
        GRID_SYNC();
    }
}

extern "C" void kernel_launch(void* const* d_in, const int* in_sizes, int n_in, void* d_out, int out_size, void* d_ws, size_t ws_size, hipStream_t stream) {
    static int grid = 0;
    if (grid == 0) {
        if (n_in != 34 || (size_t)out_size != O_END || ws_size < WS_END) {
            fprintf(stderr, "kernel_launch: unexpected problem: n_in %d out_size %d (want %zu) ws %zu (need %zu); nothing launched\n", n_in, out_size, (size_t)O_END, ws_size, (size_t)WS_END); grid = -1; return; }
        int dev = 0, cus = 0, per_cu = 0;
        (void)hipGetDevice(&dev); (void)hipDeviceGetAttribute(&cus, hipDeviceAttributeMultiprocessorCount, dev);
        if (hipFuncSetAttribute((const void*)fwd_megakernel, hipFuncAttributeMaxDynamicSharedMemorySize, LDS_BYTES) != hipSuccess) { fprintf(stderr, "kernel_launch: hipFuncSetAttribute failed\n"); }
        if (hipOccupancyMaxActiveBlocksPerMultiprocessor(&per_cu, (const void*)fwd_megakernel, NTHR, LDS_BYTES) != hipSuccess || per_cu < 1) { fprintf(stderr, "kernel_launch: occupancy query says %d\n", per_cu); per_cu = 1; }
        (void)hipGetLastError();
        grid = cus * 1;
        if (grid <= 0) grid = 256;
    }
    if (grid < 0) return;
    Params p{};
    for (int i = 0; i < 34; ++i) p.in[i] = (const float*)d_in[i];
    p.out = (float*)d_out; p.ws = (unsigned char*)d_ws;
    void* args[] = {&p};
    hipError_t e = hipLaunchCooperativeKernel((const void*)fwd_megakernel, dim3(grid), dim3(NTHR), args, LDS_BYTES, stream);
    if (e != hipSuccess) fprintf(stderr, "kernel_launch: cooperative launch failed: %s (grid %d)\n", hipGetErrorString(e), grid);
}
```

```cpp
#include <hip/hip_runtime.h>
#include <hip/hip_cooperative_groups.h>
#include <cstdio>
#include <cstdint>
namespace cg = cooperative_groups;

#define LAS __attribute__((address_space(3)))
#define DI __device__ __forceinline__
typedef unsigned short bf16_t;
typedef short bf16x8 __attribute__((ext_vector_type(8)));
typedef float f32x4 __attribute__((ext_vector_type(4)));
typedef float f32x2 __attribute__((ext_vector_type(2)));
typedef float f32x16 __attribute__((ext_vector_type(16)));
typedef unsigned u32x4 __attribute__((ext_vector_type(4)));
typedef unsigned u32x2 __attribute__((ext_vector_type(2)));
typedef __bf16 bf16x2_t __attribute__((ext_vector_type(2)));

constexpr int DM = 1024, SEQ = 2048, NBATCH = 32, DEPTH = 4, RP = NBATCH * SEQ, DB = 8, DSEQ = 32, RS = DB * DSEQ, R = RP + RS;
constexpr int PAST = 1024, INC = 2560, DFF = 2816, UPC = 2 * DFF, MEMR = NBATCH * 256, NWAVES = 8, NTHR = 512;
constexpr float EPS = 1e-6f, LOG2E = 1.4426950408889634f;
constexpr float QSCALE = 0.125f * LOG2E;
constexpr float XSCALE = 0.0625f * LOG2E;

constexpr size_t O_Y = 0;
constexpr size_t O_DKP = (size_t)R * DM;
constexpr size_t O_DVP = O_DKP + (size_t)DEPTH * RP * 512;
constexpr size_t O_MKP = O_DVP + (size_t)DEPTH * RP * 512;
constexpr size_t O_MVP = O_MKP + (size_t)DEPTH * MEMR * DM;
constexpr size_t O_FCP = O_MVP + (size_t)DEPTH * MEMR * DM;
constexpr size_t O_DKS = O_FCP + (size_t)DEPTH * NBATCH * 2 * DFF;
constexpr size_t O_DVS = O_DKS + (size_t)DEPTH * RS * 512;
constexpr size_t O_GVS = O_DVS + (size_t)DEPTH * RS * 512;
constexpr size_t O_FCS = O_GVS + (size_t)DEPTH * RS * 512;
constexpr size_t O_END = O_FCS + (size_t)DEPTH * DB * 2 * DFF;

constexpr size_t MiB = 1u << 20;
constexpr size_t WS_SSQ = 0;
constexpr size_t WS_SSQM = 6 * MiB + MiB / 2;
constexpr size_t WS_BAR = 6 * MiB + MiB / 2 + 65536;
constexpr size_t WS_SSQQ = 6 * MiB + 3 * MiB / 4;
constexpr size_t WS_LSUM = 9 * MiB;
constexpr size_t WS_W = 11 * MiB;
constexpr size_t WS_XB = 137 * MiB;
constexpr size_t WS_MB = 266 * MiB;
constexpr size_t WS_MK = 282 * MiB;
constexpr size_t WS_MVT = 298 * MiB;
constexpr size_t WS_A = 314 * MiB;
constexpr size_t WS_Z = WS_A;
constexpr size_t WS_P = WS_A;
constexpr size_t WS_H = WS_A + 322 * MiB;
constexpr size_t WS_Q = WS_A + 451 * MiB;
constexpr size_t WS_VT = WS_Q;
constexpr size_t WS_A2 = WS_A;
constexpr size_t WS_GS = WS_A + 451 * MiB;
constexpr size_t WS_US = WS_A + 474 * MiB;
constexpr size_t WS_SG = WS_A + 486 * MiB;
constexpr size_t WS_END = WS_A + 580 * MiB;
static_assert((size_t)R * INC * 2 <= 322 * MiB && (size_t)R * DM * 2 <= 129 * MiB && (size_t)R * DFF * 2 <= 451 * MiB && (size_t)(RP / 64) * 4 * DFF * 2 <= 23 * MiB && (size_t)(RP / 64) * 2 * DFF * 2 <= 12 * MiB && (size_t)RS * UPC * 2 <= 3 * MiB, "region A map");
static_assert((size_t)DEPTH * 3 * R * 8 <= WS_SSQM && WS_SSQM + MEMR * 4 <= WS_SSQQ && WS_SSQQ + (size_t)R * 32 <= WS_LSUM && WS_LSUM + (size_t)RP * 32 <= WS_W, "ctl map");
constexpr size_t WL_IN = 0, WL_OUT = WL_IN + (size_t)INC * DM, WL_Q = WL_OUT + (size_t)DM * DM, WL_K = WL_Q + (size_t)DM * DM, WL_V = WL_K + (size_t)DM * DM,
                 WL_O = WL_V + (size_t)DM * DM, WL_UP = WL_O + (size_t)DM * DM, WL_DN = WL_UP + (size_t)UPC * DM, WL_STRIDE = WL_DN + (size_t)DM * DFF;
static_assert(WS_W + DEPTH * WL_STRIDE * 2 <= WS_XB, "weights map");

constexpr int LDS_BYTES = 147456;

struct Params {
    const float* in[34];
    float* out;
    unsigned char* ws;
};
typedef const Params __attribute__((address_space(4)))* KParams;
DI KParams kparams() { KParams kp = (KParams)__builtin_amdgcn_kernarg_segment_ptr(); asm volatile("" : "+s"(kp)); return kp; }

DI unsigned pk2(float lo, float hi) { f32x2 v = {lo, hi}; bf16x2_t b = __builtin_convertvector(v, bf16x2_t); return __builtin_bit_cast(unsigned, b); }
DI float bflo(unsigned w) { return __uint_as_float(w << 16); }
DI float bfhi(unsigned w) { return __uint_as_float(w & 0xffff0000u); }
DI float wave_sum(float v) {
#pragma unroll
    for (int o = 1; o < 64; o <<= 1) v += __shfl_xor(v, o);
    return v;
}
DI float wave_max(float v) {
#pragma unroll
    for (int o = 1; o < 64; o <<= 1) v = fmaxf(v, __shfl_xor(v, o));
    return v;
}
DI float gelu_t(float x) {
    const float u = 0.7978845608028654f * (x + 0.044715f * x * x * x);
    const float e = __builtin_amdgcn_exp2f(-2.f * LOG2E * u);
    return x * __builtin_amdgcn_rcpf(1.f + e);
}
DI float silu_f(float x) { return x * __builtin_amdgcn_rcpf(1.f + __builtin_amdgcn_exp2f(-LOG2E * x)); }
DI float rstd_of(float ssq, float inv_n) { return 1.0f / sqrtf(ssq * inv_n + EPS); }
typedef unsigned long long acc_t;
constexpr float SSQ_SCALE = 1048576.0f, LS_SCALE = 16777216.0f;
DI void acc_add(acc_t* p, float v, float scale) { atomicAdd(p, (acc_t)(v * scale)); }
DI float acc_get(const acc_t* p, float inv_scale) { return (float)(*p) * inv_scale; }
DI float acc_get_i(const acc_t* base, unsigned idx, float inv_scale) { return (float)(*(const acc_t*)((const char*)base + idx * 8u)) * inv_scale; }
DI void unpack8(const u32x4 w, float (&v)[8]) {
    v[0] = bflo(w.x); v[1] = bfhi(w.x); v[2] = bflo(w.y); v[3] = bfhi(w.y); v[4] = bflo(w.z); v[5] = bfhi(w.z); v[6] = bflo(w.w); v[7] = bfhi(w.w);
}
DI u32x4 pack8(const float (&v)[8]) { u32x4 w; w.x = pk2(v[0], v[1]); w.y = pk2(v[2], v[3]); w.z = pk2(v[4], v[5]); w.w = pk2(v[6], v[7]); return w; }
template <class T> DI T* boff(T* base, unsigned byte_off) { return (T*)((char*)base + byte_off); }
DI float lam_init_of(int l) { return l == 0 ? 0.2f : l == 1 ? 0.35550906759096934f : l == 2 ? 0.4707130183435842f : 0.5560582041556406f; }
namespace pg8 {
constexpr int BM = 256, BK = 64, HALF = 128, HTB = HALF * BK * 2, STAGE_BYTES = 8 * HTB, NXCD = 8, WGM = 8;
DI int lds_byte(int r, int c) { const int st = (r >> 4) * 2 + (c >> 5), rr = r & 15, cc = c & 31, ob = rr * 64 + cc * 2; return st * 1024 + (ob ^ (((ob >> 9) & 1) << 5)); }
DI void stage_rc(int b, int& Rr, int& C) { const int st = b / 1024, sb = b % 1024, swz = sb ^ (((sb >> 9) & 1) << 5); Rr = (st >> 1) * 16 + swz / 64; C = (st & 1) * 32 + (swz % 64) / 2; }
DI int perm32(int rho) { const int n = rho >> 4, i = rho & 15; return 8 * (i >> 2) + 4 * n + (i & 3); }
struct Unit { int pm, pn; };

struct SchedStd {
    int nM, nN, nwg, G, c; const char* A; const char* B; size_t tA, tB;
    DI void init(const bf16_t* A_, int lda, const bf16_t* B_, int ldb, int M, int N, int G_, int c_) { nM = M / BM; nN = N / BM; nwg = nM * nN; G = G_; c = c_; A = (const char*)A_; B = (const char*)B_; tA = (size_t)BM * lda * 2; tB = (size_t)BM * ldb * 2; }
    DI bool next(int i, Unit& u) const {
        const long L = (long)i * G + c; if (c < 0 || L >= nwg) return false;
        int wgid = (int)L; { const int q = nwg / NXCD, r = nwg % NXCD, xcd = wgid % NXCD, off = wgid / NXCD; wgid = (xcd < r ? xcd * (q + 1) : r * (q + 1) + (xcd - r) * q) + off; }
        const int nig = WGM * nN, gid = wgid / nig, fm = gid * WGM, gsz = (nM - fm) < WGM ? (nM - fm) : WGM;
        u.pm = fm + ((wgid % nig) % gsz); u.pn = (wgid % nig) / gsz; return true;
    }
    DI const char* a_base(const Unit& u) const { return A + (size_t)u.pm * tA; }
    DI const char* b_base(const Unit& u) const { return B + (size_t)u.pn * tB; }
};
struct SchedX {
    int G, c; const char* A; const char* B; size_t bB, hB;
    DI bool next(int i, Unit& u) const { const int L = i * G + c; if (L >= (RP / BM) * 4) return false; u.pm = L >> 2; u.pn = L & 3; return true; }
    DI const char* a_base(const Unit& u) const { return A + ((size_t)u.pm * BM * DM + (size_t)u.pn * 256) * 2; }
    DI const char* b_base(const Unit& u) const { return B + (size_t)(u.pm >> 3) * bB + (size_t)u.pn * hB; }
};

template <class Epi, class Sched>
DI void gemm_phase(LAS unsigned char* lds, const int tid, const int K, const int lda, const int ldb, const Sched& S, const Epi& E) {
    const int wid = __builtin_amdgcn_readfirstlane(tid >> 6), lane = tid & 63, wr = wid >> 2, wc = wid & 3, fr = lane & 15, fq = lane >> 4;
    const int nt = K / BK;
    unsigned voffA[2], voffB[2];
#pragma unroll
    for (int i = 0; i < 2; ++i) { int Rr, C; stage_rc(tid * 16 + i * 8192, Rr, C); const int Rb = Epi::PERM ? ((Rr & ~31) + perm32(Rr & 31)) : Rr;
        voffA[i] = (unsigned)(Rr * lda + C) * 2u; voffB[i] = (unsigned)(Rb * ldb + C) * 2u; }
    const size_t kstep = (size_t)(BK * 2);
    const size_t hA = (size_t)HALF * lda * 2, hB = (size_t)HALF * ldb * 2;
    const unsigned ldsw = (unsigned)wid * 1024u;
    const int aoff = lds_byte(wr * 64 + fr, fq * 8), boff = lds_byte(wc * 32 + fr, fq * 8);
#define PG8_SA(b, h) (((b) * 2 + (h)) * HTB)
#define PG8_SB(b, h) ((4 + (b) * 2 + (h)) * HTB)
#define PG8_STAGE(bufoff, gbase, voff) do { _Pragma("unroll") for (int _i = 0; _i < 2; ++_i) \
        __builtin_amdgcn_global_load_lds((const unsigned*)((const char*)(gbase) + (voff)[_i]), (LAS unsigned*)(lds + (bufoff) + ldsw + _i * 8192), 16, 0, 0); } while (0)
#define PG8_LDA(dst, b, h) do { _Pragma("unroll") for (int m = 0; m < 4; ++m) _Pragma("unroll") for (int k = 0; k < 2; ++k) dst[m][k] = *(const LAS bf16x8*)(lds + PG8_SA(b, h) + aoff + m * 2048 + k * 1024); } while (0)
#define PG8_LDB(dst, b, h) do { _Pragma("unroll") for (int n = 0; n < 2; ++n) _Pragma("unroll") for (int k = 0; k < 2; ++k) dst[n][k] = *(const LAS bf16x8*)(lds + PG8_SB(b, h) + boff + n * 2048 + k * 1024); } while (0)
#define PG8_MMA(ai, bj, At, Bt) do { __builtin_amdgcn_s_setprio(1); _Pragma("unroll") for (int m = 0; m < 4; ++m) _Pragma("unroll") for (int n = 0; n < 2; ++n) _Pragma("unroll") for (int k = 0; k < 2; ++k) \
        acc[ai][bj][m][n] = __builtin_amdgcn_mfma_f32_16x16x32_bf16(Bt[n][k], At[m][k], acc[ai][bj][m][n], 0, 0, 0); __builtin_amdgcn_s_setprio(0); } while (0)
#define PG8_WAIT_V(n) asm volatile("s_waitcnt vmcnt(" #n ")" ::: "memory")
#define PG8_WAIT_L(n) asm volatile("s_waitcnt lgkmcnt(" #n ")" ::: "memory")
#define PG8_BAR __builtin_amdgcn_s_barrier()
#define PG8_SCHED __builtin_amdgcn_sched_barrier(0)
    Unit cur, nxt; int ui = 0;
    if (!S.next(0, cur)) return;
    f32x4 acc[2][2][4][2];
#pragma unroll
    for (int a = 0; a < 2; ++a)
#pragma unroll
        for (int b = 0; b < 2; ++b)
#pragma unroll
            for (int m = 0; m < 4; ++m)
#pragma unroll
                for (int n = 0; n < 2; ++n) acc[a][b][m][n] = (f32x4){0.f, 0.f, 0.f, 0.f};
    bf16x8 At[4][2], B0[2][2], B1[2][2];
    const char* cA = S.a_base(cur); const char* cB = S.b_base(cur);
    PG8_STAGE(PG8_SB(0, 0), cB, voffB); PG8_STAGE(PG8_SB(0, 1), cB + hB, voffB); PG8_STAGE(PG8_SA(0, 0), cA, voffA); PG8_STAGE(PG8_SA(0, 1), cA + hA, voffA);
    if (wr == 1) PG8_BAR;
    PG8_WAIT_V(2); PG8_BAR;
    PG8_STAGE(PG8_SB(1, 0), cB + kstep, voffB); PG8_STAGE(PG8_SA(1, 0), cA + kstep, voffA); PG8_STAGE(PG8_SB(1, 1), cB + hB + kstep, voffB);
    PG8_WAIT_V(6); PG8_BAR;
    for (;;) {
        const bool has_next = S.next(ui + 1, nxt);
        const char* nA = has_next ? S.a_base(nxt) : cA; const char* nB = has_next ? S.b_base(nxt) : cB;
#pragma unroll 1
        for (int t = 0; t < nt; t += 2) {
            const bool last = (t == nt - 2);
            const char* a1 = cA + (size_t)(t + 1) * kstep;
            const char* a2 = last ? nA : cA + (size_t)(t + 2) * kstep; const char* b2 = last ? nB : cB + (size_t)(t + 2) * kstep;
            const char* a3 = a2 + kstep; const char* b3 = b2 + kstep;
            PG8_LDB(B0, 0, 0); PG8_LDB(B1, 0, 1); PG8_SCHED; PG8_LDA(At, 0, 0); PG8_STAGE(PG8_SA(1, 1), a1 + hA, voffA);
            PG8_WAIT_V(8); PG8_WAIT_L(0); PG8_BAR; PG8_MMA(0, 0, At, B0); PG8_MMA(0, 1, At, B1); PG8_BAR; PG8_SCHED;
            PG8_LDA(At, 0, 1); PG8_STAGE(PG8_SB(0, 0), b2, voffB); PG8_STAGE(PG8_SB(0, 1), b2 + hB, voffB); PG8_STAGE(PG8_SA(0, 0), a2, voffA);
            PG8_WAIT_V(8); PG8_WAIT_L(0); PG8_BAR; PG8_MMA(1, 0, At, B0); PG8_MMA(1, 1, At, B1); PG8_BAR; PG8_SCHED;
            PG8_LDB(B0, 1, 0); PG8_LDB(B1, 1, 1); PG8_SCHED; PG8_LDA(At, 1, 0); PG8_STAGE(PG8_SA(0, 1), a2 + hA, voffA);
            PG8_WAIT_V(8); PG8_WAIT_L(0); PG8_BAR; PG8_MMA(0, 0, At, B0); PG8_MMA(0, 1, At, B1); PG8_BAR; PG8_SCHED;
            PG8_LDA(At, 1, 1); PG8_STAGE(PG8_SB(1, 0), b3, voffB); PG8_STAGE(PG8_SB(1, 1), b3 + hB, voffB); PG8_STAGE(PG8_SA(1, 0), a3, voffA);
            PG8_WAIT_V(8); PG8_WAIT_L(0); PG8_BAR; PG8_MMA(1, 0, At, B0); PG8_MMA(1, 1, At, B1); PG8_BAR; PG8_SCHED;
        }
        if (wr == 0) PG8_BAR;
        E(acc, cur, wr, wc, fr, fq);
        if (!has_next) break;
#pragma unroll
        for (int a = 0; a < 2; ++a)
#pragma unroll
            for (int b = 0; b < 2; ++b)
#pragma unroll
                for (int m = 0; m < 4; ++m)
#pragma unroll
                    for (int n = 0; n < 2; ++n) acc[a][b][m][n] = (f32x4){0.f, 0.f, 0.f, 0.f};
        cur = nxt; cA = nA; cB = nB; ++ui;
        if (wr == 1) PG8_BAR;
    }
    PG8_WAIT_V(0);
    PG8_BAR;
#undef PG8_SA
#undef PG8_SB
#undef PG8_STAGE
#undef PG8_LDA
#undef PG8_LDB
#undef PG8_MMA
#undef PG8_WAIT_V
#undef PG8_WAIT_L
#undef PG8_BAR
#undef PG8_SCHED
}

#define EPI_ROWS_BEGIN _Pragma("unroll") for (int ai = 0; ai < 2; ++ai) _Pragma("unroll") for (int m = 0; m < 4; ++m) { const int row = u.pm * BM + ai * HALF + wr * 64 + m * 16 + fr;
#define EPI_ROWS_END }


DI void store_pair_transposed(bf16_t* Tcol0, int pitch, int r, int fr, unsigned w01, unsigned w23, unsigned w45, unsigned w67) {
    const bool odd = fr & 1;
    const unsigned s0 = odd ? w01 : w45, s1 = odd ? w23 : w67;
    const unsigned r0 = __shfl_xor(s0, 1), r1 = __shfl_xor(s1, 1);
    const unsigned X0 = odd ? r0 : w01, X1 = odd ? r1 : w23, Y0 = odd ? w45 : r0, Y1 = odd ? w67 : r1;
    bf16_t* base = Tcol0 + (size_t)(odd ? 4 : 0) * pitch + (r & ~1);
    *(unsigned*)(base) = (X0 & 0xffffu) | (Y0 << 16);
    *(unsigned*)(base + pitch) = (X0 >> 16) | (Y0 & 0xffff0000u);
    *(unsigned*)(base + 2 * (size_t)pitch) = (X1 & 0xffffu) | (Y1 << 16);
    *(unsigned*)(base + 3 * (size_t)pitch) = (X1 >> 16) | (Y1 & 0xffff0000u);
}
struct EpiIn {
    static constexpr bool PERM = true;
    bf16_t* Z; const acc_t* ssq; float* dvp; float* dvs; bf16_t* VT; LAS float* xl; const float* qg; const float* kg; float* dkp; float* dks; const float* rope;
    DI void operator()(const f32x4 (&acc)[2][2][4][2], const Unit& u, int wr, int wc, int fr, int fq) const {
        const int colb = u.pn * BM + wc * 32 + 8 * fq;
        if (u.pn < 4) {
            int fr_ = fr, fq_ = fq, wc_ = wc, wr_ = wr; asm volatile("" : "+v"(fr_), "+v"(fq_), "+s"(wc_), "+s"(wr_));
            const int wv = wr_ * 4 + wc_;
            _Pragma("unroll") for (int ai = 0; ai < 2; ++ai) _Pragma("unroll") for (int m = 0; m < 4; ++m) { const int row = u.pm * BM + ai * HALF + wr_ * 64 + m * 16 + fr_;
                const float rs = rstd_of(acc_get_i(ssq, (unsigned)row, 1.0f / SSQ_SCALE), 1.0f / DM);
#pragma unroll
                for (int bj = 0; bj < 2; ++bj) { const f32x4 v0 = acc[ai][bj][m][0] * rs, v1 = acc[ai][bj][m][1] * rs;
                    float ss = (v0[0] * v0[0] + v0[1] * v0[1]) + (v0[2] * v0[2] + v0[3] * v0[3]) + (v1[0] * v1[0] + v1[1] * v1[1]) + (v1[2] * v1[2] + v1[3] * v1[3]);
                    ss += __shfl_xor(ss, 16); ss += __shfl_xor(ss, 32);
                    if (fq_ == 0) xl[(wv * 2 + bj) * 128 + ai * 64 + m * 16 + fr_] = ss; }
            }
            asm volatile("s_waitcnt lgkmcnt(0)" ::: "memory"); __builtin_amdgcn_s_barrier(); asm volatile("" ::: "memory");
            int pnv = u.pn; asm volatile("" : "+s"(pnv));
            const bool isq = pnv < 2, ropew = (wc_ & 1) == 0;
            const float* gp = (isq ? qg : kg) + (wc_ & 1) * 32 + 8 * fq_;
            const f32x4 g0 = *(const f32x4*)gp, g1 = *(const f32x4*)(gp + 4);
            _Pragma("unroll") for (int ai = 0; ai < 2; ++ai) _Pragma("unroll") for (int m = 0; m < 4; ++m) { const int row = u.pm * BM + ai * HALF + wr_ * 64 + m * 16 + fr_;
                const float rs = rstd_of(acc_get_i(ssq, (unsigned)row, 1.0f / SSQ_SCALE), 1.0f / DM);
                const int pos = row < RP ? (row & (SEQ - 1)) : PAST + ((row - RP) & (DSEQ - 1));
                f32x4 c0 = {1.f, 1.f, 1.f, 1.f}, c1 = c0, s0 = {0.f, 0.f, 0.f, 0.f}, s1 = s0;
                if (ropew) { const f32x4* tp = (const f32x4*)(rope + pos * 16); c0 = tp[0]; c1 = tp[1]; s0 = tp[2]; s1 = tp[3]; }
#pragma unroll
                for (int bj = 0; bj < 2; ++bj) { const int col = (u.pn * BM + wc_ * 32 + 8 * fq_) + bj * HALF;
                    const int ri = bj * 128 + ai * 64 + m * 16 + fr_;
                    const float tot = xl[(wv & ~1) * 256 + ri] + xl[(wv | 1) * 256 + ri];
                    const float rn = rs * rstd_of(tot, 1.0f / 64.f);
                    float x[8];
#pragma unroll
                    for (int j = 0; j < 4; ++j) { x[j] = acc[ai][bj][m][0][j] * rn * g0[j]; x[4 + j] = acc[ai][bj][m][1][j] * rn * g1[j]; }
                    if (ropew) {
#pragma unroll
                        for (int j = 0; j < 8; ++j) { const float other = __shfl_xor(x[j], 16);
                            const float sn = j < 4 ? s0[j & 3] : s1[j & 3], cs = j < 4 ? c0[j & 3] : c1[j & 3];
                            const float r0 = x[j] * cs - other * sn, r1 = x[j] * cs + other * sn;
                            x[j] = fq_ == 0 ? r0 : (fq_ == 1 ? r1 : x[j]); } }
                    if (!isq) { float* dst = (row < RP ? dkp + (size_t)row * 512 : dks + (size_t)(row - RP) * 512) + (col - 512);
                        *(f32x4*)dst = (f32x4){x[0], x[1], x[2], x[3]}; *(f32x4*)(dst + 4) = (f32x4){x[4], x[5], x[6], x[7]}; }
                    else {
#pragma unroll
                        for (int j = 0; j < 8; ++j) x[j] *= QSCALE; }
                    u32x4 w; w.x = pk2(x[0], x[1]); w.y = pk2(x[2], x[3]); w.z = pk2(x[4], x[5]); w.w = pk2(x[6], x[7]);
                    *(u32x4*)(Z + (size_t)row * INC + col) = w; }
                asm volatile("" ::: "memory");
            }
            return;
        }
        EPI_ROWS_BEGIN
            const float rs = rstd_of(acc_get(ssq + row, 1.0f / SSQ_SCALE), 1.0f / DM);
#pragma unroll
            for (int bj = 0; bj < 2; ++bj) { const int col = colb + bj * HALF; f32x4 v0 = acc[ai][bj][m][0] * rs, v1 = acc[ai][bj][m][1] * rs;
                if (u.pn == 4 || u.pn == 5) { float* dst = (row < RP ? dvp + (size_t)row * 512 : dvs + (size_t)(row - RP) * 512) + (col - 1024); *(f32x4*)dst = v0; *(f32x4*)(dst + 4) = v1;
                    if (u.pm < RP / BM) store_pair_transposed(VT + ((size_t)(row >> 11) * 512 + (col - 1024)) * SEQ, SEQ, ((row & (SEQ - 1)) & ~12) | ((row & 4) << 1) | ((row & 8) >> 1)  , fr, pk2(v0[0], v0[1]), pk2(v0[2], v0[3]), pk2(v1[0], v1[1]), pk2(v1[2], v1[3])); }
                else {
#pragma unroll
                    for (int j = 0; j < 4; ++j) { v0[j] = gelu_t(v0[j]); v1[j] = gelu_t(v1[j]); }
                    u32x4 w; w.x = pk2(v0[0], v0[1]); w.y = pk2(v0[2], v0[3]); w.z = pk2(v1[0], v1[1]); w.w = pk2(v1[2], v1[3]);
                    *(u32x4*)(Z + (size_t)row * INC + col) = w; } }
        EPI_ROWS_END
    }
};

struct EpiKV {
    static constexpr bool PERM = true;
    bf16_t* MK; const float* ssq; float* mvp; bf16_t* MVT;
    DI void operator()(const f32x4 (&acc)[2][2][4][2], const Unit& u, int wr, int wc, int fr, int fq) const {
        const int colb = (u.pn & 3) * BM + wc * 32 + 8 * fq;
        EPI_ROWS_BEGIN
            const float rs = rstd_of(ssq[row], 1.0f / DM);
#pragma unroll
            for (int bj = 0; bj < 2; ++bj) { const int col = colb + bj * HALF; const f32x4 v0 = acc[ai][bj][m][0] * rs, v1 = acc[ai][bj][m][1] * rs;
                if (u.pn >= 4) { float* dst = mvp + (size_t)row * DM + col; *(f32x4*)dst = v0; *(f32x4*)(dst + 4) = v1;
                    store_pair_transposed(MVT + ((size_t)(row >> 8) * DM + col) * 256, 256, row & 255, fr, pk2(v0[0], v0[1]), pk2(v0[2], v0[3]), pk2(v1[0], v1[1]), pk2(v1[2], v1[3])); }
                else { u32x4 w; w.x = pk2(v0[0], v0[1]); w.y = pk2(v0[2], v0[3]); w.z = pk2(v1[0], v1[1]); w.w = pk2(v1[2], v1[3]); *(u32x4*)(MK + (size_t)row * DM + col) = w; } }
        EPI_ROWS_END
    }
};
struct EpiRes {
    static constexpr bool PERM = true;
    float* Y; bf16_t* XB; acc_t* ssq_next;
    DI void operator()(const f32x4 (&acc)[2][2][4][2], const Unit& u, int wr, int wc, int fr, int fq) const {
        const int colb = u.pn * BM + wc * 32 + 8 * fq;
        EPI_ROWS_BEGIN
            float ss = 0.f;
#pragma unroll
            for (int bj = 0; bj < 2; ++bj) { const int col = colb + bj * HALF; bf16_t* xp = XB + (size_t)row * DM + col;
                float xv[8]; unpack8(*(const u32x4*)xp, xv);
                const f32x4 x0 = (f32x4){xv[0], xv[1], xv[2], xv[3]} + acc[ai][bj][m][0], x1 = (f32x4){xv[4], xv[5], xv[6], xv[7]} + acc[ai][bj][m][1];
                if (Y != nullptr) { float* yp = Y + (size_t)row * DM + col; *(f32x4*)yp = x0; *(f32x4*)(yp + 4) = x1; }
                u32x4 w; w.x = pk2(x0[0], x0[1]); w.y = pk2(x0[2], x0[3]); w.z = pk2(x1[0], x1[1]); w.w = pk2(x1[2], x1[3]); *(u32x4*)xp = w;
                ss += (x0[0] * x0[0] + x0[1] * x0[1]) + (x0[2] * x0[2] + x0[3] * x0[3]) + (x1[0] * x1[0] + x1[1] * x1[1]) + (x1[2] * x1[2] + x1[3] * x1[3]); }
            ss += __shfl_xor(ss, 16); ss += __shfl_xor(ss, 32);
            if (ssq_next != nullptr && fq == 0) acc_add(ssq_next + row, ss, SSQ_SCALE);
        EPI_ROWS_END
    }
};

struct EpiQ {
    static constexpr bool PERM = true;
    bf16_t* Q; const acc_t* ssq; acc_t* ssqq;
    DI void operator()(const f32x4 (&acc)[2][2][4][2], const Unit& u, int wr, int wc, int fr, int fq) const {
        const int colb = u.pn * BM + wc * 32 + 8 * fq;
        EPI_ROWS_BEGIN
            const float rs = rstd_of(acc_get(ssq + row, 1.0f / SSQ_SCALE), 1.0f / DM); float ss = 0.f;
#pragma unroll
            for (int bj = 0; bj < 2; ++bj) { const int col = colb + bj * HALF; const f32x4 v0 = acc[ai][bj][m][0] * rs, v1 = acc[ai][bj][m][1] * rs;
                u32x4 w; w.x = pk2(v0[0], v0[1]); w.y = pk2(v0[2], v0[3]); w.z = pk2(v1[0], v1[1]); w.w = pk2(v1[2], v1[3]); *(u32x4*)(Q + (size_t)row * DM + col) = w;
                ss += (v0[0] * v0[0] + v0[1] * v0[1]) + (v0[2] * v0[2] + v0[3] * v0[3]) + (v1[0] * v1[0] + v1[1] * v1[1]) + (v1[2] * v1[2] + v1[3] * v1[3]); }
            ss += __shfl_xor(ss, 16); ss += __shfl_xor(ss, 32);
            if (fq == 0) acc_add(ssqq + (size_t)row * 4 + u.pn, ss, SSQ_SCALE);
        EPI_ROWS_END
    }
};
struct EpiS {
    static constexpr bool PERM = true;
    bf16_t* P; const acc_t* ssqq; acc_t* lsum;
    DI void operator()(const f32x4 (&acc)[2][2][4][2], const Unit& u, int wr, int wc, int fr, int fq) const {
        const int colb = u.pn * BM + wc * 32 + 8 * fq;
        EPI_ROWS_BEGIN
            const float rs = rstd_of(acc_get(ssqq + (size_t)row * 4 + u.pn, 1.0f / SSQ_SCALE), 1.0f / 256.f) * XSCALE; float ss = 0.f;
#pragma unroll
            for (int bj = 0; bj < 2; ++bj) { const int col = colb + bj * HALF; f32x4 v0 = acc[ai][bj][m][0] * rs, v1 = acc[ai][bj][m][1] * rs;
#pragma unroll
                for (int j = 0; j < 4; ++j) { v0[j] = __builtin_amdgcn_exp2f(v0[j]); v1[j] = __builtin_amdgcn_exp2f(v1[j]); }
                u32x4 w; w.x = pk2(v0[0], v0[1]); w.y = pk2(v0[2], v0[3]); w.z = pk2(v1[0], v1[1]); w.w = pk2(v1[2], v1[3]); *(u32x4*)(P + (size_t)row * DM + col) = w;
                ss += (v0[0] + v0[1]) + (v0[2] + v0[3]) + (v1[0] + v1[1]) + (v1[2] + v1[3]); }
            ss += __shfl_xor(ss, 16); ss += __shfl_xor(ss, 32);
            if (fq == 0) acc_add(lsum + (size_t)row * 4 + u.pn, ss, LS_SCALE);
        EPI_ROWS_END
    }
};
struct EpiPV {
    static constexpr bool PERM = true;
    bf16_t* H; const acc_t* lsum;
    DI void operator()(const f32x4 (&acc)[2][2][4][2], const Unit& u, int wr, int wc, int fr, int fq) const {
        const int colb = u.pn * BM + wc * 32 + 8 * fq;
        EPI_ROWS_BEGIN
            const float rs = 1.0f / acc_get(lsum + (size_t)row * 4 + u.pn, 1.0f / LS_SCALE);
#pragma unroll
            for (int bj = 0; bj < 2; ++bj) { const int col = colb + bj * HALF; const f32x4 v0 = acc[ai][bj][m][0] * rs, v1 = acc[ai][bj][m][1] * rs;
                u32x4 w; w.x = pk2(v0[0], v0[1]); w.y = pk2(v0[2], v0[3]); w.z = pk2(v1[0], v1[1]); w.w = pk2(v1[2], v1[3]); *(u32x4*)(H + (size_t)row * DM + col) = w; }
        EPI_ROWS_END
    }
};
struct EpiUpAct {
    static constexpr bool PERM = true;
    bf16_t* A2; const acc_t* ssq; bf16_t* GS; bf16_t* US; bf16_t* SG; const float* cw; const float* cb; float* fcp; float* fcs;
    DI void operator()(const f32x4 (&acc)[2][2][4][2], const Unit& u, int wr, int wc, int fr, int fq) const {
        const int c8 = u.pn * HALF + wc * 32 + 8 * fq;
        if (u.pm == RP / BM) {
            Unit uu = u; asm volatile("" : "+s"(uu.pm));
            const Unit& u = uu;
            EPI_ROWS_BEGIN
                const float rs = rstd_of(acc_get(ssq + row, 1.0f / SSQ_SCALE), 1.0f / DM); const int sr = row - RP;
#pragma unroll
                for (int bj = 0; bj < 2; ++bj) { const f32x4 v0 = acc[ai][bj][m][0] * rs, v1 = acc[ai][bj][m][1] * rs;
                    u32x4 w; w.x = pk2(v0[0], v0[1]); w.y = pk2(v0[2], v0[3]); w.z = pk2(v1[0], v1[1]); w.w = pk2(v1[2], v1[3]); *(u32x4*)(SG + (size_t)sr * UPC + bj * DFF + c8) = w;
                    if (bj == 0 && (sr & 31) >= 30) { float* dst = fcs + ((size_t)(sr >> 5) * 2 + ((sr & 31) - 30)) * DFF + c8; *(f32x4*)dst = v0; *(f32x4*)(dst + 4) = v1; } }
            EPI_ROWS_END
            return;
        }
        const int src1 = (fq << 4) | ((fr + 15) & 15), src2 = (fq << 4) | ((fr + 14) & 15);
#pragma unroll
        for (int n = 0; n < 2; ++n) {
            const int c4 = c8 + 4 * n;
            const f32x4 w0 = *(const f32x4*)(cw + c4), w1 = *(const f32x4*)(cw + DFF + c4), w2 = *(const f32x4*)(cw + 2 * DFF + c4), cbv = *(const f32x4*)(cb + c4);
#pragma unroll
            for (int ai = 0; ai < 2; ++ai) {
                f32x4 pg = {0.f, 0.f, 0.f, 0.f};
#pragma unroll
                for (int m = 0; m < 4; ++m) { const int row = u.pm * BM + ai * HALF + wr * 64 + m * 16 + fr;
                    const float rs = rstd_of(acc_get_i(ssq, (unsigned)row, 1.0f / SSQ_SCALE), 1.0f / DM);
                    const f32x4 g = acc[ai][0][m][n] * rs, up = acc[ai][1][m][n] * rs;
                    f32x4 a;
#pragma unroll
                    for (int j = 0; j < 4; ++j) { const float s1 = __shfl(fr == 15 ? pg[j] : g[j], src1), s2 = __shfl(fr >= 14 ? pg[j] : g[j], src2);
                        a[j] = silu_f(cbv[j] + w0[j] * s2 + w1[j] * s1 + w2[j] * g[j]) * up[j]; }
                    u32x2 gw; gw.x = pk2(g[0], g[1]); gw.y = pk2(g[2], g[3]);
                    if (m == 0 && fr < 2) {
                        *boff((u32x2*)GS, (unsigned)(((row >> 6) * 4 + 2 + fr) * DFF + c4) * 2u) = gw;
                        u32x2 uw; uw.x = pk2(up[0], up[1]); uw.y = pk2(up[2], up[3]); *boff((u32x2*)US, (unsigned)(((row >> 6) * 2 + fr) * DFF + c4) * 2u) = uw;
                    } else { u32x2 w; w.x = pk2(a[0], a[1]); w.y = pk2(a[2], a[3]); *boff((u32x2*)A2, (unsigned)(row * DFF + c4) * 2u) = w; }
                    if (m == 3 && fr >= 14) {
                        *boff((u32x2*)GS, (unsigned)(((row >> 6) * 4 + (fr - 14)) * DFF + c4) * 2u) = gw;
                        if ((row & (SEQ - 1)) >= SEQ - 2) *boff((f32x4*)fcp, (unsigned)(((row >> 11) * 2 + ((row & (SEQ - 1)) - (SEQ - 2))) * DFF + c4) * 4u) = g;
                    }
                    pg = g;
                    asm volatile("" ::: "memory");
                }
            }
        }
    }
};

}
template <bool UPMAP = false>
DI void transpose_item(const float* W, int K, int N, bf16_t* WT, const float* gain, LAS float* scr, int item, int lane) {
    const int nblk = N / 32, kb = item / nblk, nb = item % nblk, k0 = 64 * kb, n0 = 32 * nb;
    const int r0 = !UPMAP ? n0 : (n0 < DFF ? ((n0 >> 7) << 8) + (n0 & 127) : (((n0 - DFF) >> 7) << 8) + 128 + ((n0 - DFF) & 127));
#pragma unroll
    for (int i = 0; i < 32; ++i) { const int kk = 2 * i + (lane >> 5); float v = W[(size_t)(k0 + kk) * N + n0 + (lane & 31)]; if (gain) v *= gain[k0 + kk]; scr[kk * 33 + (lane & 31)] = v; }
    asm volatile("s_waitcnt lgkmcnt(0)" ::: "memory");
    const int c = lane & 7;
#pragma unroll
    for (int j = 0; j < 4; ++j) { const int n = (lane >> 3) + 8 * j; const LAS float* s = scr + (8 * c) * 33 + n;
        u32x4 o; o.x = pk2(s[0 * 33], s[1 * 33]); o.y = pk2(s[2 * 33], s[3 * 33]); o.z = pk2(s[4 * 33], s[5 * 33]); o.w = pk2(s[6 * 33], s[7 * 33]);
        *(u32x4*)(WT + (size_t)(r0 + n) * K + k0 + 8 * c) = o; }
    asm volatile("s_waitcnt lgkmcnt(0)" ::: "memory");
}
template <bool UPMAP = false>
DI void convert_matrix(const float* W, int K, int N, bf16_t* WT, const float* gain, LAS float* scr, int gw, int ngw, int lane) {
    const int nitems = (K / 64) * (N / 32);
    for (int it = gw; it < nitems; it += ngw) transpose_item<UPMAP>(W, K, N, WT, gain, scr, it, lane);
}

DI void convert_layer_weights(int l, int part, LAS float* scr, int gw, int ngw, int lane) {
    bf16_t* wl = (bf16_t*)(kparams()->ws + WS_W) + (size_t)l * WL_STRIDE;
    if (part < 0 || part == 0) {
        { KParams p = kparams(); convert_matrix(p->in[9] + (size_t)l * DM * INC, DM, INC, wl + WL_IN, p->in[8] + l * DM, scr, gw, ngw, lane); }
        { KParams p = kparams(); convert_matrix(p->in[20] + (size_t)l * DM * DM, DM, DM, wl + WL_OUT, nullptr, scr, gw, ngw, lane); } }
    if (part < 0 || part == 1) {
        { KParams p = kparams(); convert_matrix(p->in[23] + (size_t)l * DM * DM, DM, DM, wl + WL_Q, p->in[21] + l * DM, scr, gw, ngw, lane); }
        { KParams p = kparams(); convert_matrix(p->in[24] + (size_t)l * DM * DM, DM, DM, wl + WL_K, p->in[22] + l * DM, scr, gw, ngw, lane); }
        { KParams p = kparams(); convert_matrix(p->in[25] + (size_t)l * DM * DM, DM, DM, wl + WL_V, p->in[22] + l * DM, scr, gw, ngw, lane); }
        { KParams p = kparams(); convert_matrix(p->in[26] + (size_t)l * DM * DM, DM, DM, wl + WL_O, nullptr, scr, gw, ngw, lane); } }
    if (part < 0 || part == 2) {
        { KParams p = kparams(); convert_matrix<true>(p->in[30] + (size_t)l * DM * UPC, DM, UPC, wl + WL_UP, p->in[29] + l * DM, scr, gw, ngw, lane); }
        { KParams p = kparams(); convert_matrix(p->in[33] + (size_t)l * DFF * DM, DFF, DM, wl + WL_DN, nullptr, scr, gw, ngw, lane); } }
}
DI void phase_prologue(LAS unsigned char* lds, int gw, int ngw, int wid, int lane) {
    LAS float* scr = (LAS float*)(lds + wid * 16384);
    convert_layer_weights(0, -1, scr, gw, ngw, lane);
    KParams p = kparams();
    acc_t* ssq = (acc_t*)(p->ws + WS_SSQ); bf16_t* XB = (bf16_t*)(p->ws + WS_XB);
    const float* xp = p->in[0]; const float* xs = p->in[1];
    for (int row0 = gw; row0 < R; row0 += 4 * ngw) {
        f32x4 v[4][4];
#pragma unroll
        for (int i = 0; i < 4; ++i) { const int row = row0 + i * ngw; if (row < R) { const float* src = row < RP ? xp + (size_t)row * DM : xs + (size_t)(row - RP) * DM;
#pragma unroll
            for (int j = 0; j < 4; ++j) v[i][j] = *(const f32x4*)(src + 4 * lane + 256 * j); } }
#pragma unroll
        for (int i = 0; i < 4; ++i) { const int row = row0 + i * ngw; if (row < R) { float ss = 0.f;
#pragma unroll
            for (int j = 0; j < 4; ++j) { const f32x4 x = v[i][j]; u32x2 w; w.x = pk2(x[0], x[1]); w.y = pk2(x[2], x[3]); *(u32x2*)(XB + (size_t)row * DM + 4 * lane + 256 * j) = w;
                ss += (x[0] * x[0] + x[1] * x[1]) + (x[2] * x[2] + x[3] * x[3]); }
            ss = wave_sum(ss); if (lane == 0) ssq[row] = (acc_t)(ss * SSQ_SCALE); } }
    }
    float* ssqm = (float*)(p->ws + WS_SSQM); bf16_t* MB = (bf16_t*)(p->ws + WS_MB);
    for (int row = gw; row < MEMR; row += ngw) {
        const float* src = p->in[7] + (size_t)row * DM; float ss = 0.f;
#pragma unroll
        for (int j = 0; j < 4; ++j) { const f32x4 v = *(const f32x4*)(src + 4 * lane + 256 * j);
            u32x2 w; w.x = pk2(v[0], v[1]); w.y = pk2(v[2], v[3]); *(u32x2*)(MB + (size_t)row * DM + 4 * lane + 256 * j) = w;
            ss += (v[0] * v[0] + v[1] * v[1]) + (v[2] * v[2] + v[3] * v[3]); }
        ss = wave_sum(ss); if (lane == 0) ssqm[row] = ss;
    }
    { float* rope = (float*)(p->ws + WS_END);
      const float hi_[8] = {1.5905761719e-01f, 3.0853271484e-02f, 5.9814453125e-03f, 1.1606216431e-03f, 2.2506713867e-04f, 4.3630599976e-05f, 8.4638595581e-06f, 1.6409903765e-06f};
      const float lo_[8] = {9.7325901152e-05f, 1.0491919966e-05f, 3.7404001887e-06f, 4.1998173828e-08f, 1.1940367806e-08f, 1.7352817849e-08f, 4.7125015001e-10f, 4.3588632703e-10f};
      for (int pos = gw * 64 + lane; pos < 2080; pos += ngw * 64) { const float fp = (float)pos;
#pragma unroll
          for (int j = 0; j < 8; ++j) { float t = fp * hi_[j]; t = t - rintf(t); t += fp * lo_[j]; rope[pos * 16 + j] = __builtin_amdgcn_cosf(t); rope[pos * 16 + 8 + j] = __builtin_amdgcn_sinf(t); } } }
    for (int i = R + gw * 64 + lane; i < DEPTH * 3 * R; i += ngw * 64) ssq[i] = 0ull;
}

DI void qk_post_row(bf16_t* Z, int row, const u32x4 w0, const u32x4 w1, const float* qg, const float* kg, float* dkp, float* dks, int lane) {
    bf16_t* ptr = Z + (size_t)row * INC + lane * 16;
    float a[8], b[8]; unpack8(w0, a); unpack8(w1, b);
    float ss = 0.f;
#pragma unroll
    for (int i = 0; i < 8; ++i) ss += a[i] * a[i] + b[i] * b[i];
    ss += __shfl_xor(ss, 1); ss += __shfl_xor(ss, 2);
    const float rs = rstd_of(ss, 1.0f / 64.f);
    const bool isq = lane < 32;
    const float* g = (isq ? qg : kg) + (lane & 3) * 16;
#pragma unroll
    for (int i = 0; i < 8; ++i) { a[i] *= rs * g[i]; b[i] *= rs * g[8 + i]; }
    const int pos = row < RP ? (row & (SEQ - 1)) : PAST + ((row - RP) & (DSEQ - 1));
    if ((lane & 3) == 0) {
        const float fp = (float)pos;
        const float hi[8] = {1.5905761719e-01f, 3.0853271484e-02f, 5.9814453125e-03f, 1.1606216431e-03f, 2.2506713867e-04f, 4.3630599976e-05f, 8.4638595581e-06f, 1.6409903765e-06f};
        const float lo[8] = {9.7325901152e-05f, 1.0491919966e-05f, 3.7404001887e-06f, 4.1998173828e-08f, 1.1940367806e-08f, 1.7352817849e-08f, 4.7125015001e-10f, 4.3588632703e-10f};
#pragma unroll
        for (int i = 0; i < 8; ++i) {
            float t = fp * hi[i]; t = t - rintf(t); t += fp * lo[i];
            const float sn = __builtin_amdgcn_sinf(t), cs = __builtin_amdgcn_cosf(t);
            const float x1 = a[i], x2 = b[i]; a[i] = x1 * cs - x2 * sn; b[i] = x2 * cs + x1 * sn; }
    }
    if (!isq) {
        float* dst = (row < RP ? dkp + (size_t)row * 512 : dks + (size_t)(row - RP) * 512) + (lane - 32) * 16;
        *(f32x4*)dst = (f32x4){a[0], a[1], a[2], a[3]}; *(f32x4*)(dst + 4) = (f32x4){a[4], a[5], a[6], a[7]};
        *(f32x4*)(dst + 8) = (f32x4){b[0], b[1], b[2], b[3]}; *(f32x4*)(dst + 12) = (f32x4){b[4], b[5], b[6], b[7]};
    } else {
#pragma unroll
        for (int i = 0; i < 8; ++i) { a[i] *= QSCALE; b[i] *= QSCALE; }
    }
    *(u32x4*)ptr = pack8(a); *(u32x4*)(ptr + 8) = pack8(b);
}
DI void qk_post_rows(bf16_t* Z, int gw, int ngw, const float* qg, const float* kg, float* dkp, float* dks, int lane) {
    for (int row = gw; row < R; row += 8 * ngw) {
        u32x4 w0[8], w1[8];
#pragma unroll
        for (int i = 0; i < 8; ++i) { const int r = row + i * ngw; if (r < R) { const bf16_t* ptr = Z + (size_t)r * INC + lane * 16; w0[i] = *(const u32x4*)ptr; w1[i] = *(const u32x4*)(ptr + 8); } }
#pragma unroll
        for (int i = 0; i < 8; ++i) { const int r = row + i * ngw; if (r < R) qk_post_row(Z, r, w0[i], w1[i], qg, kg, dkp, dks, lane); }
    }
}
DI void memk_post_row(bf16_t* MK, int row, const u32x4 w0, const u32x4 w1, const float* xkg, const float* xqg, float* mkp, int lane) {
    bf16_t* ptr = MK + (size_t)row * DM + lane * 16;
    float a[8], b[8]; unpack8(w0, a); unpack8(w1, b);
    float ss = 0.f;
#pragma unroll
    for (int i = 0; i < 8; ++i) ss += a[i] * a[i] + b[i] * b[i];
    ss += __shfl_xor(ss, 1); ss += __shfl_xor(ss, 2); ss += __shfl_xor(ss, 4); ss += __shfl_xor(ss, 8);
    const float rs = rstd_of(ss, 1.0f / 256.f);
    const int d0 = (lane & 15) * 16;
#pragma unroll
    for (int i = 0; i < 8; ++i) { a[i] *= rs * xkg[d0 + i]; b[i] *= rs * xkg[d0 + 8 + i]; }
    float* dst = mkp + (size_t)row * DM + lane * 16;
    *(f32x4*)dst = (f32x4){a[0], a[1], a[2], a[3]}; *(f32x4*)(dst + 4) = (f32x4){a[4], a[5], a[6], a[7]};
    *(f32x4*)(dst + 8) = (f32x4){b[0], b[1], b[2], b[3]}; *(f32x4*)(dst + 12) = (f32x4){b[4], b[5], b[6], b[7]};
#pragma unroll
    for (int i = 0; i < 8; ++i) { a[i] *= xqg[d0 + i]; b[i] *= xqg[d0 + 8 + i]; }
    *(u32x4*)ptr = pack8(a); *(u32x4*)(ptr + 8) = pack8(b);
}

DI void memk_post_rows(bf16_t* MK, int gw, int ngw, const float* xkg, const float* xqg, float* mkp, int lane) {
    for (int row = gw; row < MEMR; row += 4 * ngw) {
        u32x4 w0[4], w1[4];
#pragma unroll
        for (int i = 0; i < 4; ++i) { const int r = row + i * ngw; if (r < MEMR) { const bf16_t* ptr = MK + (size_t)r * DM + lane * 16; w0[i] = *(const u32x4*)ptr; w1[i] = *(const u32x4*)(ptr + 8); } }
#pragma unroll
        for (int i = 0; i < 4; ++i) { const int r = row + i * ngw; if (r < MEMR) memk_post_row(MK, r, w0[i], w1[i], xkg, xqg, mkp, lane); }
    }
}

#define MFMA32(a, b, c) __builtin_amdgcn_mfma_f32_32x32x16_bf16((a), (b), (c), 0, 0, 0)
DI int crow(int r, int hi) { return (r & 3) + 8 * (r >> 2) + 4 * hi; }

DI void gate_unit(int un, int& cached_g, const bf16_t* Z, bf16_t* H, const float* Wsl, const float* gmb, const float* gmg, LAS unsigned char* lds, int tid, int wid, int lane) {
    const int b = un >> 6, n = (un >> 2) & 15, g = un & 3, row0 = b * SEQ + n * 128;
    LAS unsigned char* Ws = lds; LAS unsigned char* Gt = lds + 128 * 272;
    const int r32 = lane & 31, hi = lane >> 5, tblk = wid & 3, cp = wid >> 2;
    const int t = tblk * 32 + r32, row = row0 + t; const float bias = gmb[g * 128 + t];
    u32x2 uw[2][4];
#pragma unroll
    for (int cc = 0; cc < 2; ++cc)
#pragma unroll
        for (int rg = 0; rg < 4; ++rg) uw[cc][rg] = *(const u32x2*)(Z + (size_t)row * INC + 1536 + g * 128 + (2 * cp + cc) * 32 + 8 * rg + 4 * hi);
    if (g != cached_g) {
        cached_g = g;
        const float* wsrc = Wsl + (size_t)g * 128 * 128;
#pragma unroll
        for (int i = 0; i < 8; ++i) { const int idx = tid + NTHR * i, t = idx >> 5, s4 = (idx & 31) * 4; f32x4 v = *(const f32x4*)(wsrc + t * 128 + s4);
#pragma unroll
            for (int j = 0; j < 4; ++j) if (s4 + j > t) v[j] = 0.f;
            u32x2 w; w.x = pk2(v[0], v[1]); w.y = pk2(v[2], v[3]); *(LAS u32x2*)(Ws + t * 272 + s4 * 2) = w; }
    }
#pragma unroll
    for (int i = 0; i < 4; ++i) { const int idx = tid + NTHR * i, s = idx >> 4, ch = idx & 15;
        const u32x4 w = *(const u32x4*)(Z + (size_t)(row0 + s) * INC + 2048 + g * 128 + ch * 8); float v[8]; unpack8(w, v);
        float ss = 0.f;
#pragma unroll
        for (int j = 0; j < 8; ++j) ss += v[j] * v[j];
        ss += __shfl_xor(ss, 1); ss += __shfl_xor(ss, 2); ss += __shfl_xor(ss, 4); ss += __shfl_xor(ss, 8);
        const float rs = rstd_of(ss, 1.0f / 128.f);
#pragma unroll
        for (int j = 0; j < 8; j += 2) { const unsigned pw = pk2(v[j] * rs * gmg[ch * 8 + j], v[j + 1] * rs * gmg[ch * 8 + j + 1]);
            *(LAS bf16_t*)(Gt + (ch * 8 + j) * 272 + ((s ^ (ch << 3)) << 1)) = (bf16_t)(pw & 0xffffu); *(LAS bf16_t*)(Gt + (ch * 8 + j + 1) * 272 + ((s ^ (ch << 3)) << 1)) = (bf16_t)(pw >> 16); } }
    __syncthreads();
    f32x16 acc[2];
#pragma unroll
    for (int i = 0; i < 16; ++i) { acc[0][i] = 0.f; acc[1][i] = 0.f; }
    const int nks = 2 * (tblk + 1);
    for (int ks = 0; ks < nks; ++ks) {
        const bf16x8 bf = *(const LAS bf16x8*)(Ws + (tblk * 32 + r32) * 272 + (ks * 16 + hi * 8) * 2);
#pragma unroll
        for (int cc = 0; cc < 2; ++cc) { const int crow_ = (2 * cp + cc) * 32 + r32; const bf16x8 af = *(const LAS bf16x8*)(Gt + crow_ * 272 + (((ks * 2 + hi) ^ (crow_ >> 3)) << 4)); acc[cc] = MFMA32(af, bf, acc[cc]); }
    }
#pragma unroll
    for (int cc = 0; cc < 2; ++cc)
#pragma unroll
        for (int rg = 0; rg < 4; ++rg) { const int c0 = (2 * cp + cc) * 32 + 8 * rg + 4 * hi;
            const u32x2 uv = uw[cc][rg];
            u32x2 o; o.x = pk2(bflo(uv.x) * (acc[cc][4 * rg] + bias), bfhi(uv.x) * (acc[cc][4 * rg + 1] + bias)); o.y = pk2(bflo(uv.y) * (acc[cc][4 * rg + 2] + bias), bfhi(uv.y) * (acc[cc][4 * rg + 3] + bias));
            *(u32x2*)(H + (size_t)row * DM + 512 + g * 128 + c0) = o; }
    __syncthreads();
}
DI void gate_sample_unit(int un, const bf16_t* Z, bf16_t* H, const float* Wsl, const float* gmb, const float* gmg, float* gvs, LAS unsigned char* lds, int tid, int wid, int lane) {
    const int b = un >> 2, g = un & 3, row0 = RP + b * DSEQ;
    LAS float* gvn = (LAS float*)lds;
    for (int s = wid; s < DSEQ; s += NWAVES) {
        const unsigned w = *(const unsigned*)(Z + (size_t)(row0 + s) * INC + 2048 + g * 128 + 2 * lane);
        const float v0 = bflo(w), v1 = bfhi(w); const float ss = wave_sum(v0 * v0 + v1 * v1); const float rs = rstd_of(ss, 1.0f / 128.f);
        const float n0 = v0 * rs * gmg[2 * lane], n1 = v1 * rs * gmg[2 * lane + 1];
        gvn[s * 128 + 2 * lane] = n0; gvn[s * 128 + 2 * lane + 1] = n1;
        *(f32x2*)(gvs + (size_t)(b * DSEQ + s) * 512 + g * 128 + 2 * lane) = (f32x2){n0, n1};
    }
    LAS float* wl_ = gvn + DSEQ * 128;
    for (int i = tid; i < DSEQ * DSEQ; i += NTHR) wl_[(i >> 5) * 33 + (i & 31)] = Wsl[(size_t)g * 128 * 128 + (i >> 5) * 128 + (i & 31)];
    __syncthreads();
#pragma unroll
    for (int k = 0; k < 8; ++k) { const int idx = tid + NTHR * k, t = idx >> 7, c = idx & 127; float acc = 0.f;
        const LAS float* wr_ = wl_ + t * 33;
#pragma unroll 16
        for (int s = 0; s < DSEQ; ++s) acc += (s <= t ? wr_[s] : 0.f) * gvn[s * 128 + c];
        const float uu = bflo((unsigned)Z[(size_t)(row0 + t) * INC + 1536 + g * 128 + c]);
        const unsigned pw = pk2(uu * (acc + gmb[g * 128 + t]), 0.f);
        H[(size_t)(row0 + t) * DM + 512 + g * 128 + c] = (bf16_t)(pw & 0xffffu); }
    __syncthreads();
}

DI void diff_attn_unit(int b, int h, int qb, const bf16_t* Z, const bf16_t* VT, bf16_t* H, float lam, const float* subg, float oscale, LAS unsigned char* lds, int wid, int lane) {
    const int r32 = lane & 31, hi = lane >> 5, mp = wid >> 2, wq = wid & 3;
    const int qrow = b * SEQ + qb * 128 + wq * 32 + r32;
    bf16x8 qf[4];
#pragma unroll
    for (int ks = 0; ks < 4; ++ks) qf[ks] = *(const bf16x8*)(Z + (size_t)qrow * INC + h * 128 + mp * 64 + ks * 16 + hi * 8);
    const int ntile = 2 * qb + 2, mylast = 2 * qb + (wq >> 1);
    const bf16_t* kg[2]; const bf16_t* vg[2];
#pragma unroll
    for (int i = 0; i < 2; ++i) { const int q = i * 8 + wid;
        { const int row = 4 * q + (lane >> 4), c = (lane & 15) ^ (row & 15); kg[i] = Z + (size_t)(b * SEQ + row) * INC + 512 + h * 128 + c * 8; }
        { const int row = 8 * q + (lane >> 3), c = (lane & 7) ^ (row & 7); vg[i] = VT + (size_t)((b * 4 + h) * 128 + row) * SEQ + c * 8; } }
#define DA_ISSUE(t, buf) do { _Pragma("unroll") for (int i_ = 0; i_ < 2; ++i_) { \
        __builtin_amdgcn_global_load_lds((const unsigned*)(kg[i_] + (size_t)(t) * 64 * INC), (LAS unsigned*)(lds + (buf) * 32768 + (i_ * 8 + wid) * 1024), 16, 0, 0); \
        __builtin_amdgcn_global_load_lds((const unsigned*)(vg[i_] + (size_t)(t) * 64), (LAS unsigned*)(lds + (buf) * 32768 + 16384 + (i_ * 8 + wid) * 1024), 16, 0, 0); } } while (0)
    f32x16 O[4];
#pragma unroll
    for (int d = 0; d < 4; ++d)
#pragma unroll
        for (int i = 0; i < 16; ++i) O[d][i] = 0.f;
    float ls = 0.f;
    DA_ISSUE(0, 0);
    asm volatile("s_waitcnt vmcnt(0)" ::: "memory"); __syncthreads();
    for (int t = 0; t < ntile; ++t) {
        const int buf = t & 1;
        if (t + 1 < ntile) DA_ISSUE(t + 1, buf ^ 1);
        if (t <= mylast) {
            const LAS unsigned char* kb = lds + buf * 32768; const LAS unsigned char* vb = kb + 16384;
            f32x16 s0, s1;
#pragma unroll
            for (int i = 0; i < 16; ++i) { s0[i] = 0.f; s1[i] = 0.f; }
#pragma unroll
            for (int ks = 0; ks < 4; ++ks) { const int c = mp * 8 + ks * 2 + hi; const int off = r32 * 256 + ((c ^ (r32 & 15)) << 4);
                const bf16x8 a0 = *(const LAS bf16x8*)(kb + off), a1 = *(const LAS bf16x8*)(kb + 8192 + off);
                s0 = MFMA32(a0, qf[ks], s0); s1 = MFMA32(a1, qf[ks], s1); }
#pragma unroll
            for (int i = 0; i < 16; ++i) { s0[i] = __builtin_amdgcn_exp2f(s0[i]); s1[i] = __builtin_amdgcn_exp2f(s1[i]); ls += s0[i] + s1[i]; }
            bf16x8 pb[4]; u32x4 w;
            w.x = pk2(s0[0], s0[1]); w.y = pk2(s0[2], s0[3]); w.z = pk2(s0[4], s0[5]); w.w = pk2(s0[6], s0[7]); pb[0] = __builtin_bit_cast(bf16x8, w);
            w.x = pk2(s0[8], s0[9]); w.y = pk2(s0[10], s0[11]); w.z = pk2(s0[12], s0[13]); w.w = pk2(s0[14], s0[15]); pb[1] = __builtin_bit_cast(bf16x8, w);
            w.x = pk2(s1[0], s1[1]); w.y = pk2(s1[2], s1[3]); w.z = pk2(s1[4], s1[5]); w.w = pk2(s1[6], s1[7]); pb[2] = __builtin_bit_cast(bf16x8, w);
            w.x = pk2(s1[8], s1[9]); w.y = pk2(s1[10], s1[11]); w.z = pk2(s1[12], s1[13]); w.w = pk2(s1[14], s1[15]); pb[3] = __builtin_bit_cast(bf16x8, w);
#pragma unroll
            for (int d = 0; d < 4; ++d)
#pragma unroll
                for (int j = 0; j < 4; ++j) { const int row = 32 * d + r32;
                    const bf16x8 a = *(const LAS bf16x8*)(vb + row * 128 + (((2 * j + hi) ^ (row & 7)) << 4));
                    O[d] = MFMA32(a, pb[j], O[d]); }
        }
        asm volatile("s_waitcnt vmcnt(0)" ::: "memory"); __syncthreads();
    }
#undef DA_ISSUE
    ls += __shfl_xor(ls, 32);
    LAS float* xch = (LAS float*)(lds + wq * 16384);
    if (mp == 1) { const float i1 = lam / ls;
#pragma unroll
        for (int d = 0; d < 4; ++d)
#pragma unroll
            for (int i = 0; i < 16; ++i) xch[(d * 16 + i) * 64 + lane] = O[d][i] * i1; }
    __syncthreads();
    if (mp == 0) { const float i0 = 1.0f / ls; float ss = 0.f;
#pragma unroll
        for (int d = 0; d < 4; ++d)
#pragma unroll
            for (int i = 0; i < 16; ++i) { const float o = O[d][i] * i0 - xch[(d * 16 + i) * 64 + lane]; O[d][i] = o; ss += o * o; }
        ss += __shfl_xor(ss, 32);
        const float rs = rstd_of(ss, 1.0f / 128.f) * oscale;
        bf16_t* hp = H + (size_t)qrow * DM + h * 128;
#pragma unroll
        for (int d = 0; d < 4; ++d)
#pragma unroll
            for (int rg = 0; rg < 4; ++rg) { const int d0 = 32 * d + 8 * rg + 4 * hi; const f32x4 g4 = *(const f32x4*)(subg + d0);
                u32x2 o; o.x = pk2(O[d][4 * rg] * rs * g4[0], O[d][4 * rg + 1] * rs * g4[1]); o.y = pk2(O[d][4 * rg + 2] * rs * g4[2], O[d][4 * rg + 3] * rs * g4[3]);
                *(u32x2*)(hp + d0) = o; } }
    __syncthreads();
}

DI void diff_attn_sample_pair(int it, int hf, int l, const float* cdk, const float* cdv, const float* outp, const bf16_t* Z, bf16_t* H, float lam, const float* subg, float oscale, LAS unsigned char* lds, int wid, int lane) {
    const int srow = it >> 2, h = it & 3, b = srow >> 5;
    LAS float* qs = (LAS float*)(lds + wid * 16384);
    LAS float* ps = qs + 128; LAS float* xst = ps + 2 * 544; LAS float* xacc = xst + 4;
    const LAS float* ost = (const LAS float*)(lds + (wid ^ 1) * 16384) + 128 + 2 * 544; const LAS float* oacc = ost + 4;
    const int NKH = 544, nkl = hf ? 544 : 512, j0g = hf * 512;
    { const unsigned w = *(const unsigned*)(Z + (size_t)(RP + srow) * INC + h * 128 + 2 * lane); qs[2 * lane] = bflo(w); qs[2 * lane + 1] = bfhi(w); }
    asm volatile("s_waitcnt lgkmcnt(0)" ::: "memory");
    const float* ck = cdk + (size_t)(l * DB + b) * PAST * 512 + h * 128;
    const float* nk = outp + O_DKS + (size_t)(l * DB + b) * DSEQ * 512 + h * 128;
    float mx[2] = {-3.0e38f, -3.0e38f};
    for (int jj = lane; jj < nkl; jj += 64) { const int j = j0g + jj;
        const float* kp = j < PAST ? ck + (size_t)j * 512 : nk + (size_t)(j - PAST) * 512;
#pragma unroll
        for (int m = 0; m < 2; ++m) { float dot = 0.f;
#pragma unroll
            for (int d = 0; d < 64; d += 4) { const f32x4 kv = *(const f32x4*)(kp + m * 64 + d); dot += kv[0] * qs[m * 64 + d] + kv[1] * qs[m * 64 + d + 1] + kv[2] * qs[m * 64 + d + 2] + kv[3] * qs[m * 64 + d + 3]; }
            ps[m * NKH + jj] = dot; mx[m] = fmaxf(mx[m], dot); }
    }
    float lsum[2], mm[2];
#pragma unroll
    for (int m = 0; m < 2; ++m) { mm[m] = wave_max(mx[m]); float s = 0.f;
        for (int jj = lane; jj < nkl; jj += 64) { const float e = __builtin_amdgcn_exp2f(ps[m * NKH + jj] - mm[m]); ps[m * NKH + jj] = e; s += e; }
        lsum[m] = wave_sum(s); }
    asm volatile("s_waitcnt lgkmcnt(0)" ::: "memory");
    const float* cv = cdv + (size_t)(l * DB + b) * PAST * 512 + h * 128 + 2 * lane;
    const float* nv = outp + O_DVS + (size_t)(l * DB + b) * DSEQ * 512 + h * 128 + 2 * lane;
    f32x2 a0 = {0.f, 0.f}, a1 = {0.f, 0.f};
#pragma unroll 1
    for (int jb = 0; jb < nkl; jb += 32) {
        const float* vp = (j0g + jb) < PAST ? cv + (size_t)(j0g + jb) * 512 : nv + (size_t)(j0g + jb - PAST) * 512;
        f32x2 v[32];
#pragma unroll
        for (int j = 0; j < 32; ++j) v[j] = *(const f32x2*)(vp + (size_t)j * 512);
#pragma unroll
        for (int j = 0; j < 32; ++j) { a0 += v[j] * ps[jb + j]; a1 += v[j] * ps[NKH + jb + j]; }
    }
    if (lane == 0) { xst[0] = mm[0]; xst[1] = mm[1]; xst[2] = lsum[0]; xst[3] = lsum[1]; }
    *(LAS f32x4*)(xacc + 4 * lane) = (f32x4){a0[0], a0[1], a1[0], a1[1]};
    __syncthreads();
    { const float om0 = ost[0], om1 = ost[1], ol0 = ost[2], ol1 = ost[3]; const f32x4 oa = *(const LAS f32x4*)(oacc + 4 * lane);
      const float M0 = fmaxf(mm[0], om0), M1 = fmaxf(mm[1], om1);
      const float f0 = __builtin_amdgcn_exp2f(mm[0] - M0), g0 = __builtin_amdgcn_exp2f(om0 - M0), f1 = __builtin_amdgcn_exp2f(mm[1] - M1), g1 = __builtin_amdgcn_exp2f(om1 - M1);
      const float l0 = hf ? ol0 * g0 + lsum[0] * f0 : lsum[0] * f0 + ol0 * g0, l1 = hf ? ol1 * g1 + lsum[1] * f1 : lsum[1] * f1 + ol1 * g1;
      const float n00 = hf ? oa[0] * g0 + a0[0] * f0 : a0[0] * f0 + oa[0] * g0, n01 = hf ? oa[1] * g0 + a0[1] * f0 : a0[1] * f0 + oa[1] * g0;
      const float n10 = hf ? oa[2] * g1 + a1[0] * f1 : a1[0] * f1 + oa[2] * g1, n11 = hf ? oa[3] * g1 + a1[1] * f1 : a1[1] * f1 + oa[3] * g1;
      const float i0 = 1.0f / l0, i1 = lam / l1;
      const float o0 = n00 * i0 - n10 * i1, o1 = n01 * i0 - n11 * i1;
      const float ss = wave_sum(o0 * o0 + o1 * o1); const float rs = rstd_of(ss, 1.0f / 128.f) * oscale;
      if (hf == 0) *(unsigned*)(H + (size_t)(RP + srow) * DM + h * 128 + 2 * lane) = pk2(o0 * rs * subg[2 * lane], o1 * rs * subg[2 * lane + 1]); }
}

DI void cross_attn_sample_pair(int it, int hf, int l, const float* cmk, const float* cmv, const bf16_t* Q, const acc_t* ssqq, const float* xqg, bf16_t* H, LAS unsigned char* lds, int wid, int lane) {
    const int srow = it >> 2, h = it & 3, b = srow >> 5, row = RP + srow;
    LAS float* qs = (LAS float*)(lds + wid * 16384);
    LAS float* ps = qs + 256; LAS float* xst = ps + 128; LAS float* xacc = xst + 4;
    const LAS float* ost = (const LAS float*)(lds + (wid ^ 1) * 16384) + 256 + 128; const LAS float* oacc = ost + 4;
    { const u32x2 w = *(const u32x2*)(Q + (size_t)row * DM + h * 256 + 4 * lane); const float rs = rstd_of(acc_get(ssqq + (size_t)row * 4 + h, 1.0f / SSQ_SCALE), 1.0f / 256.f) * XSCALE;
      const f32x4 g4 = *(const f32x4*)(xqg + 4 * lane);
      qs[4 * lane] = bflo(w.x) * rs * g4[0]; qs[4 * lane + 1] = bfhi(w.x) * rs * g4[1]; qs[4 * lane + 2] = bflo(w.y) * rs * g4[2]; qs[4 * lane + 3] = bfhi(w.y) * rs * g4[3]; }
    asm volatile("s_waitcnt lgkmcnt(0)" ::: "memory");
    const float* ck = cmk + ((size_t)(l * DB + b) * 256 + hf * 128) * DM + h * 256;
    float sc[2]; float mx = -3.0e38f;
#pragma unroll
    for (int k = 0; k < 2; ++k) { const float* kp = ck + (size_t)(lane + 64 * k) * DM; float dot = 0.f;
#pragma unroll 1
        for (int d0 = 0; d0 < 256; d0 += 64) { f32x4 kv[16];
#pragma unroll
            for (int d = 0; d < 16; ++d) kv[d] = *(const f32x4*)(kp + d0 + 4 * d);
#pragma unroll
            for (int d = 0; d < 16; ++d) dot += kv[d][0] * qs[d0 + 4 * d] + kv[d][1] * qs[d0 + 4 * d + 1] + kv[d][2] * qs[d0 + 4 * d + 2] + kv[d][3] * qs[d0 + 4 * d + 3]; }
        sc[k] = dot; mx = fmaxf(mx, dot); }
    mx = wave_max(mx); float s = 0.f;
#pragma unroll
    for (int k = 0; k < 2; ++k) { const float e = __builtin_amdgcn_exp2f(sc[k] - mx); ps[lane + 64 * k] = e; s += e; }
    s = wave_sum(s);
    asm volatile("s_waitcnt lgkmcnt(0)" ::: "memory");
    const float* cv = cmv + ((size_t)(l * DB + b) * 256 + hf * 128) * DM + h * 256 + 4 * lane;
    f32x4 acc = {0.f, 0.f, 0.f, 0.f};
#pragma unroll 1
    for (int jb = 0; jb < 128; jb += 16) { f32x4 v[16];
#pragma unroll
        for (int j = 0; j < 16; ++j) v[j] = *(const f32x4*)(cv + (size_t)(jb + j) * DM);
#pragma unroll
        for (int j = 0; j < 16; ++j) acc += v[j] * ps[jb + j]; }
    if (lane == 0) { xst[0] = mx; xst[1] = s; }
    *(LAS f32x4*)(xacc + 4 * lane) = acc;
    __syncthreads();
    { const float om = ost[0], os = ost[1]; const f32x4 oa = *(const LAS f32x4*)(oacc + 4 * lane);
      const float M = fmaxf(mx, om), f = __builtin_amdgcn_exp2f(mx - M), g = __builtin_amdgcn_exp2f(om - M);
      const float lt = hf ? os * g + s * f : s * f + os * g;
      const f32x4 n = hf ? oa * g + acc * f : acc * f + oa * g;
      const float inv = 1.0f / lt;
      if (hf == 0) { u32x2 o; o.x = pk2(n[0] * inv, n[1] * inv); o.y = pk2(n[2] * inv, n[3] * inv); *(u32x2*)(H + (size_t)row * DM + h * 256 + 4 * lane) = o; } }
}

DI void act_fix_item(int item, const bf16_t* GS, const bf16_t* US, bf16_t* A2, const float* cw, const float* cb) {
    const int cch = item % (DFF / 8), rest = item / (DFF / 8), f = rest & 1, k = rest >> 1, c0 = cch * 8, row = 64 * k + f;
    const bool seq_start = (k & 31) == 0;
    float gm2[8], gm1[8], g[8], up[8], a[8];
    if (f == 0) {
        if (seq_start) {
#pragma unroll
            for (int j = 0; j < 8; ++j) { gm2[j] = 0.f; gm1[j] = 0.f; } }
        else { unpack8(*(const u32x4*)(GS + ((size_t)(k - 1) * 4 + 0) * DFF + c0), gm2); unpack8(*(const u32x4*)(GS + ((size_t)(k - 1) * 4 + 1) * DFF + c0), gm1); }
        unpack8(*(const u32x4*)(GS + ((size_t)k * 4 + 2) * DFF + c0), g);
    } else {
        if (seq_start) {
#pragma unroll
            for (int j = 0; j < 8; ++j) gm2[j] = 0.f; }
        else unpack8(*(const u32x4*)(GS + ((size_t)(k - 1) * 4 + 1) * DFF + c0), gm2);
        unpack8(*(const u32x4*)(GS + ((size_t)k * 4 + 2) * DFF + c0), gm1); unpack8(*(const u32x4*)(GS + ((size_t)k * 4 + 3) * DFF + c0), g);
    }
    unpack8(*(const u32x4*)(US + ((size_t)k * 2 + f) * DFF + c0), up);
#pragma unroll
    for (int j = 0; j < 8; ++j) a[j] = silu_f(cb[c0 + j] + cw[c0 + j] * gm2[j] + cw[DFF + c0 + j] * gm1[j] + cw[2 * DFF + c0 + j] * g[j]) * up[j];
    *(u32x4*)(A2 + (size_t)row * DFF + c0) = pack8(a);
}
DI void act_sample_item(int item, const bf16_t* SG, bf16_t* A2s, const float* cw, const float* cb, const float* hist  ) {
    const int cch = item % (DFF / 8), sb = item / (DFF / 8), c0 = cch * 8;
    float w0[8], w1[8], w2[8], bb[8], g2[8], g1[8], g0[8], up[8];
#pragma unroll
    for (int j = 0; j < 8; ++j) { w0[j] = cw[c0 + j]; w1[j] = cw[DFF + c0 + j]; w2[j] = cw[2 * DFF + c0 + j]; bb[j] = cb[c0 + j]; }
    { const float* hp = hist + (size_t)sb * 2 * DFF + c0;
#pragma unroll
      for (int j = 0; j < 8; ++j) { g0[j] = hp[j]; g1[j] = hp[DFF + j]; } }
#pragma unroll 1
    for (int r0 = 0; r0 < DSEQ; r0 += 4) {
        u32x4 gw[4], uw[4];
#pragma unroll
        for (int i = 0; i < 4; ++i) { const bf16_t* gp = SG + (size_t)(sb * DSEQ + r0 + i) * UPC + c0; gw[i] = *(const u32x4*)gp; uw[i] = *(const u32x4*)(gp + DFF); }
#pragma unroll
        for (int i = 0; i < 4; ++i) { unpack8(gw[i], g2); unpack8(uw[i], up);
            float a[8];
#pragma unroll
            for (int j = 0; j < 8; ++j) { const float c = bb[j] + w0[j] * g0[j] + w1[j] * g1[j] + w2[j] * g2[j]; a[j] = silu_f(c) * up[j]; g0[j] = g1[j]; g1[j] = g2[j]; }
            *(u32x4*)(A2s + (size_t)(sb * DSEQ + r0 + i) * DFF + c0) = pack8(a); }
    }
}
#define XB_TMO      128
#define XB_XCNT(j)  (256  + 64 * (j))
#define XB_XSUB(j)  (1280 + 64 * (j))
#define XB_XGEN(j)  (2304 + 64 * (j))
#define XB_TOP      3328
#define XB_TOPGEN   3392
#define XCD_BAR_WORDS 3456
#define XB_SPIN_CAP (1u << 18)

DI unsigned xb_ld(unsigned* p)              { return __hip_atomic_load(p, __ATOMIC_RELAXED, __HIP_MEMORY_SCOPE_AGENT); }
DI unsigned xb_add(unsigned* p, unsigned v) { return __hip_atomic_fetch_add(p, v, __ATOMIC_RELAXED, __HIP_MEMORY_SCOPE_AGENT); }
DI unsigned xb_xcc_id() { return (unsigned)__builtin_amdgcn_s_getreg((3 << 11) | 20) & 0xFu; }
#define XB_SPIN(cond, bar) do { unsigned _sp = 0; while (cond) { __builtin_amdgcn_s_sleep(1); \
    if ((++_sp & 255u) == 0u) { if (xb_ld(&(bar)[XB_TMO])) break; if (_sp > XB_SPIN_CAP) { atomicAdd(&(bar)[XB_TMO], 1u); break; } } } } while (0)

struct XcdBarrier {
    unsigned* bar; unsigned x;
    volatile LAS unsigned* st;
};

DI bool xb_tid0(int wid) { unsigned m_ = ~0u; int w_ = wid; asm volatile("" : "+s"(m_), "+s"(w_)); return w_ == 0 && __builtin_amdgcn_mbcnt_hi(m_, __builtin_amdgcn_mbcnt_lo(m_, 0u)) == 0u; }
DI XcdBarrier xcd_barrier_post(unsigned* bar, volatile LAS unsigned* st, int wid) {
    XcdBarrier b; b.bar = bar; b.x = xb_xcc_id(); b.st = st;
    if (xb_tid0(wid)) (void)xb_add(&bar[XB_XCNT(b.x)], 1u);
    return b;
}
DI void xcd_barrier_complete(unsigned* bar, unsigned x, unsigned& nloc, unsigned& nx) {
    const unsigned G = gridDim.x * gridDim.y * gridDim.z;
    unsigned sum, cnt, mine, sp = 0u;
    for (;;) {
        sum = 0u; cnt = 0u; mine = 0u;
#pragma unroll
        for (unsigned j = 0; j < 16; ++j) { const unsigned c = xb_ld(&bar[XB_XCNT(j)]); sum += c; cnt += (c > 0u) ? 1u : 0u; mine = (j == x) ? c : mine; }
        if (sum == G) break;
        __builtin_amdgcn_s_sleep(1);
        if ((++sp & 255u) == 0u) { if (xb_ld(&bar[XB_TMO])) break; if (sp > XB_SPIN_CAP) { atomicAdd(&bar[XB_TMO], 1u); break; } }
    }
    nloc = mine > 0u ? mine : 1u; nx = cnt > 0u ? cnt : 1u;
}

DI void xcd_barrier(const XcdBarrier& b, int wid) {
    asm volatile("s_waitcnt vmcnt(0)" ::: "memory");
    __syncthreads();
    if (xb_tid0(wid)) {
        unsigned* bar = b.bar;
        __builtin_amdgcn_s_waitcnt(0);
        unsigned nloc = b.st[0], nx = b.st[1];
        if (nloc == 0u) { xcd_barrier_complete(bar, b.x, nloc, nx); b.st[0] = nloc; b.st[1] = nx; }
        const unsigned old = xb_add(&bar[XB_XSUB(b.x)], 1u);
        const unsigned gen = old / nloc;
        if (old + 1u == (gen + 1u) * nloc) {
            __builtin_amdgcn_fence(__ATOMIC_RELEASE, "agent");
            asm volatile("s_waitcnt vmcnt(0)" ::: "memory");
            const unsigned og = xb_add(&bar[XB_TOP], 1u);
            const unsigned tg = og / nx;
            if (og + 1u == (tg + 1u) * nx) xb_add(&bar[XB_TOPGEN], 1u);
            else XB_SPIN(xb_ld(&bar[XB_TOPGEN]) == tg, bar);
            __builtin_amdgcn_fence(__ATOMIC_ACQUIRE, "agent");
            xb_add(&bar[XB_XGEN(b.x)], 1u);
            asm volatile("s_waitcnt vmcnt(0)" ::: "memory");
        } else {
            XB_SPIN(xb_ld(&bar[XB_XGEN(b.x)]) == gen, bar);
            __builtin_amdgcn_fence(__ATOMIC_ACQUIRE, "agent");
            asm volatile("s_waitcnt vmcnt(0)" ::: "memory");
        }
    }
    __syncthreads();
}

__global__ void __launch_bounds__(NTHR, 2) fwd_megakernel(Params p_unused) {
    extern __shared__ __attribute__((aligned(16))) unsigned char lds_raw[];
    LAS unsigned char* lds = (LAS unsigned char*)lds_raw;
    cg::grid_group grid = cg::this_grid();
    const int G = gridDim.x, bx = blockIdx.x, ngw = G * NWAVES;
const int wid_s = __builtin_amdgcn_readfirstlane((int)threadIdx.x >> 6);
#define LAUNDER_T int wid = wid_s, bx_ = bx; asm volatile("" : "+s"(wid), "+s"(bx_)); unsigned m1_ = ~0u; asm volatile("" : "+s"(m1_)); const int lane = (int)__builtin_amdgcn_mbcnt_hi(m1_, __builtin_amdgcn_mbcnt_lo(m1_, 0u)); const int tid = (wid << 6) | lane, gw = bx * NWAVES + wid; (void)gw;
    { LAUNDER_T
      if (bx == 0) { unsigned* bw = (unsigned*)(kparams()->ws + WS_BAR); for (int i = tid; i < XCD_BAR_WORDS; i += NTHR) bw[i] = 0u; }
      if (tid < 2) ((LAS unsigned*)(lds + 131072 + 256))[tid] = 0u;
      phase_prologue(lds, gw, ngw, wid, lane); }
    grid.sync();
    XcdBarrier xbar = xcd_barrier_post((unsigned*)(kparams()->ws + WS_BAR), (volatile LAS unsigned*)(lds + 131072 + 256), wid_s);
#define GRID_SYNC() xcd_barrier(xbar, wid_s)

#define LAUNDER_L LAUNDER_T int l = l_; asm volatile("" : "+s"(l)); const KParams p = kparams(); unsigned char* ws = p->ws; float* outp = p->out; (void)outp;
#define WL ((const bf16_t*)(ws + WS_W) + (size_t)l * WL_STRIDE)
#define SSQ(n) ((acc_t*)(ws + WS_SSQ) + (size_t)(l * 3 + (n)) * R)
    for (int l_ = 0; l_ < DEPTH; ++l_) {
        { LAUNDER_L
          { pg8::SchedStd S; S.init((const bf16_t*)(ws + WS_XB), DM, WL + WL_IN, DM, R, INC, G, bx_);
            pg8::EpiIn E{(bf16_t*)(ws + WS_Z), SSQ(0), outp + O_DVP + (size_t)l * RP * 512, outp + O_DVS + (size_t)l * RS * 512, (bf16_t*)(ws + WS_VT), (LAS float*)(lds + 131072 + 1024), p->in[10] + l * 64, p->in[11] + l * 64, outp + O_DKP + (size_t)l * RP * 512, outp + O_DKS + (size_t)l * RS * 512, (const float*)(ws + WS_END)}; pg8::gemm_phase(lds, tid, DM, DM, DM, S, E); }
          if (l == 0) { pg8::SchedStd S; S.init((const bf16_t*)(ws + WS_MB), DM, WL + WL_K, DM, MEMR, 2 * DM, G, bx_);
            pg8::EpiKV E{(bf16_t*)(ws + WS_MK), (const float*)(ws + WS_SSQM), outp + O_MVP + (size_t)l * MEMR * DM, (bf16_t*)(ws + WS_MVT)}; pg8::gemm_phase(lds, tid, DM, DM, DM, S, E); } }
        GRID_SYNC();

        { LAUNDER_L
            bf16_t* Z = (bf16_t*)(ws + WS_Z); bf16_t* H = (bf16_t*)(ws + WS_H); bf16_t* MK = (bf16_t*)(ws + WS_MK);
            float* mkp = outp + O_MKP + (size_t)l * MEMR * DM;
            memk_post_rows(MK, gw, ngw, p->in[28] + l * 256, p->in[27] + l * 256, mkp, lane);
            acc_t* ssqq = (acc_t*)(ws + WS_SSQQ); acc_t* lsum = (acc_t*)(ws + WS_LSUM);
            for (int i = gw * 64 + lane; i < R * 4; i += ngw * 64) ssqq[i] = 0ull;
            for (int i = gw * 64 + lane; i < RP * 4; i += ngw * 64) lsum[i] = 0ull;
            __syncthreads();
            const float* Wsl = p->in[18] + (size_t)l * 4 * 128 * 128; const float* gmb = p->in[19] + l * 512; const float* gmg = p->in[17] + l * 128;
            int cached_g = -1;
            for (int un = bx; un < NBATCH * 16 * 4; un += G) gate_unit(un, cached_g, Z, H, Wsl, gmb, gmg, lds, tid, wid, lane);
            for (int un = bx; un < DB * 4; un += G) gate_sample_unit(un, Z, H, Wsl, gmb, gmg, outp + O_GVS + (size_t)l * RS * 512, lds, tid, wid, lane);
        }
        GRID_SYNC();

        { LAUNDER_L
            const bf16_t* Z = (const bf16_t*)(ws + WS_Z); bf16_t* H = (bf16_t*)(ws + WS_H); const bf16_t* VT = (const bf16_t*)(ws + WS_VT);
            const float lam_init = lam_init_of(l);
            float lam;
            { const float a = wave_sum(p->in[12][l * 64 + lane] * p->in[13][l * 64 + lane]), b = wave_sum(p->in[14][l * 64 + lane] * p->in[15][l * 64 + lane]);
              lam = __builtin_bit_cast(float, __builtin_amdgcn_readfirstlane(__builtin_bit_cast(int, expf(a) - expf(b) + lam_init))); }
            const float* subg = p->in[16] + l * 128; const float oscale = 1.0f - lam_init;
            for (int pr = bx; pr < NBATCH * 4 * 8; pr += G) { const int bh = pr >> 3, s = pr & 7;
                diff_attn_unit(bh >> 2, bh & 3, s, Z, VT, H, lam, subg, oscale, lds, wid, lane);
                diff_attn_unit(bh >> 2, bh & 3, 15 - s, Z, VT, H, lam, subg, oscale, lds, wid, lane); }
            for (int base = bx * 4; base < RS * 4; base += G * 4) { diff_attn_sample_pair(base + (wid >> 1), wid & 1, l, p->in[2], p->in[3], outp, Z, H, lam, subg, oscale, lds, wid, lane); __syncthreads(); }
        }
        GRID_SYNC();

        { LAUNDER_L pg8::SchedStd S; S.init((const bf16_t*)(ws + WS_H), DM, WL + WL_OUT, DM, R, DM, G, bx_); pg8::EpiRes E{nullptr, (bf16_t*)(ws + WS_XB), SSQ(1)}; pg8::gemm_phase(lds, tid, DM, DM, DM, S, E); }
        if (l_ + 1 < DEPTH && bx >= 4) { LAUNDER_T int ln = l_ + 1; asm volatile("" : "+s"(ln));
            convert_layer_weights(ln, 0, (LAS float*)(lds + wid * 16384), (bx - 4) * NWAVES + wid, (G - 4) * NWAVES, lane); }
        GRID_SYNC();

        { LAUNDER_L pg8::SchedStd S; S.init((const bf16_t*)(ws + WS_XB), DM, WL + WL_Q, DM, R, DM, G, bx_); pg8::EpiQ E{(bf16_t*)(ws + WS_Q), SSQ(1), (acc_t*)(ws + WS_SSQQ)}; pg8::gemm_phase(lds, tid, DM, DM, DM, S, E); }
        if (l_ + 1 < DEPTH && bx >= 4) { LAUNDER_T int ln = l_ + 1; asm volatile("" : "+s"(ln));
            convert_layer_weights(ln, 1, (LAS float*)(lds + wid * 16384), (bx - 4) * NWAVES + wid, (G - 4) * NWAVES, lane); }
        GRID_SYNC();

        { LAUNDER_L
          { pg8::SchedX S{G, bx_, (const char*)(ws + WS_Q), (const char*)(ws + WS_MK), (size_t)256 * DM * 2, (size_t)256 * 2}; pg8::EpiS E{(bf16_t*)(ws + WS_P), (const acc_t*)(ws + WS_SSQQ), (acc_t*)(ws + WS_LSUM)}; pg8::gemm_phase(lds, tid, 256, DM, DM, S, E); }
          for (int base = bx * 4; base < RS * 4; base += G * 4) { cross_attn_sample_pair(base + (wid >> 1), wid & 1, l, p->in[4], p->in[5], (const bf16_t*)(ws + WS_Q), (const acc_t*)(ws + WS_SSQQ), p->in[27] + l * 256, (bf16_t*)(ws + WS_H), lds, wid, lane); __syncthreads(); } }

        { LAUNDER_L pg8::SchedX S{G, bx_, (const char*)(ws + WS_P), (const char*)(ws + WS_MVT), (size_t)DM * 256 * 2, (size_t)256 * 256 * 2}; pg8::EpiPV E{(bf16_t*)(ws + WS_H), (const acc_t*)(ws + WS_LSUM)}; pg8::gemm_phase(lds, tid, 256, DM, 256, S, E); }
        GRID_SYNC();

        { LAUNDER_L pg8::SchedStd S; S.init((const bf16_t*)(ws + WS_H), DM, WL + WL_O, DM, R, DM, G, bx_); pg8::EpiRes E{nullptr, (bf16_t*)(ws + WS_XB), SSQ(2)}; pg8::gemm_phase(lds, tid, DM, DM, DM, S, E); }
        if (l_ + 1 < DEPTH && bx >= 4) { LAUNDER_T int ln = l_ + 1; asm volatile("" : "+s"(ln));
            convert_layer_weights(ln, 2, (LAS float*)(lds + wid * 16384), (bx - 4) * NWAVES + wid, (G - 4) * NWAVES, lane); }
        GRID_SYNC();

        { LAUNDER_L pg8::SchedStd S; S.init((const bf16_t*)(ws + WS_XB), DM, WL + WL_UP, DM, R, UPC, G, bx_);
          pg8::EpiUpAct E{(bf16_t*)(ws + WS_A2), SSQ(2), (bf16_t*)(ws + WS_GS), (bf16_t*)(ws + WS_US), (bf16_t*)(ws + WS_SG), p->in[31] + (size_t)l * 3 * DFF, p->in[32] + (size_t)l * DFF,
                              outp + O_FCP + (size_t)l * NBATCH * 2 * DFF, outp + O_FCS + (size_t)l * DB * 2 * DFF}; pg8::gemm_phase(lds, tid, DM, DM, DM, S, E); }
        GRID_SYNC();

        { LAUNDER_L
            const float* cw = p->in[31] + (size_t)l * 3 * DFF; const float* cb = p->in[32] + (size_t)l * DFF; const float* hist = p->in[6] + (size_t)l * DB * 2 * DFF;
            for (int item = bx * NTHR + tid; item < (RP / 64) * 2 * (DFF / 8); item += G * NTHR) act_fix_item(item, (const bf16_t*)(ws + WS_GS), (const bf16_t*)(ws + WS_US), (bf16_t*)(ws + WS_A2), cw, cb);
            for (int item = bx * NTHR + tid; item < DB * (DFF / 8); item += G * NTHR) act_sample_item(item, (const bf16_t*)(ws + WS_SG), (bf16_t*)(ws + WS_A2) + (size_t)RP * DFF, cw, cb, hist);
        }
        GRID_SYNC();

        { LAUNDER_L pg8::SchedStd S; S.init((const bf16_t*)(ws + WS_A2), DFF, WL + WL_DN, DFF, R, DM, G, bx_);
          pg8::EpiRes E{(l + 1 < DEPTH) ? nullptr : outp + O_Y, (bf16_t*)(ws + WS_XB), (l + 1 < DEPTH) ? (acc_t*)(ws + WS_SSQ) + (size_t)((l + 1) * 3) * R : nullptr}; pg8::gemm_phase(lds, tid, DFF, DFF, DFF, S, E); }
        { LAUNDER_L
          if (l + 1 < DEPTH) { const bf16_t* wn = (const bf16_t*)(ws + WS_W) + (size_t)(l + 1) * WL_STRIDE;
            pg8::SchedStd S2; S2.init((const bf16_t*)(ws + WS_MB), DM, wn + WL_K, DM, MEMR, 2 * DM, G - 4, bx_ - 4);
            pg8::EpiKV E2{(bf16_t*)(ws + WS_MK), (const float*)(ws + WS_SSQM), outp + O_MVP + (size_t)(l + 1) * MEMR * DM, (bf16_t*)(ws + WS_MVT)}; pg8::gemm_phase(lds, tid, DM, DM, DM, S2, E2); } }
        GRID_SYNC();
    }
}

extern "C" void kernel_launch(void* const* d_in, const int* in_sizes, int n_in, void* d_out, int out_size, void* d_ws, size_t ws_size, hipStream_t stream) {
    static int grid = 0;
    if (grid == 0) {
        if (n_in != 34 || (size_t)out_size != O_END || ws_size < WS_END) {
            fprintf(stderr, "kernel_launch: unexpected problem: n_in %d out_size %d (want %zu) ws %zu (need %zu); nothing launched\n", n_in, out_size, (size_t)O_END, ws_size, (size_t)WS_END); grid = -1; return; }
        int dev = 0, cus = 0, per_cu = 0;
        (void)hipGetDevice(&dev); (void)hipDeviceGetAttribute(&cus, hipDeviceAttributeMultiprocessorCount, dev);
        if (hipFuncSetAttribute((const void*)fwd_megakernel, hipFuncAttributeMaxDynamicSharedMemorySize, LDS_BYTES) != hipSuccess) { fprintf(stderr, "kernel_launch: hipFuncSetAttribute failed\n"); }
        if (hipOccupancyMaxActiveBlocksPerMultiprocessor(&per_cu, (const void*)fwd_megakernel, NTHR, LDS_BYTES) != hipSuccess || per_cu < 1) { fprintf(stderr, "kernel_launch: occupancy query says %d\n", per_cu); per_cu = 1; }
        (void)hipGetLastError();
        grid = cus * 1;
        if (grid <= 0) grid = 256;
    }
    if (grid < 0) return;
    Params p{};
    for (int i = 0; i < 34; ++i) p.in[i] = (const float*)d_in[i];
    p.out = (float*)d_out; p.ws = (unsigned char*)d_ws;
    void* args[] = {&p};
    hipError_t e = hipLaunchCooperativeKernel((const void*)fwd_megakernel, dim3(grid), dim3(NTHR), args, LDS_BYTES, stream);
    if (e != hipSuccess) fprintf(stderr, "kernel_launch: cooperative launch failed: %s (grid %d)\n", hipGetErrorString(e), grid);
}
```
